# Optimizing an MI355X kernel written in HIP

```python
import math
import jax, jax.numpy as jnp
from jax import lax
import numpy as np

D_MODEL = 2048
BATCH = 2
SEQ = 16384
DEPTH = 2

CTX_LEN = 256
GRID_W = 64
Q_BLOCK = 128
ROPE_THETA = 10000.0
RMS_EPS = 1e-6

MIX_GROUP_W = D_MODEL // 4
MLA_HEADS = 4
MLA_V = MIX_GROUP_W // MLA_HEADS
MLA_NOPE = MLA_V
MLA_ROPE = MLA_NOPE // 2
MLA_Q_RANK = 3 * D_MODEL // 16
MLA_KV_RANK = D_MODEL // 16
MLA_IN = MLA_Q_RANK + MLA_KV_RANK + MLA_ROPE
GQA_HEADS = 4
GQA_KV_HEADS = 2
GQA_HD = MIX_GROUP_W // GQA_HEADS
GQA_IN = (GQA_HEADS + 2 * GQA_KV_HEADS) * GQA_HD
SSM_W = MIX_GROUP_W
SSM_GROUP_CH = 16
SSM_GROUPS = SSM_W // SSM_GROUP_CH
SSM_STATE = 64
SSM_DT_MIN = 0.001
SSM_DT_MAX = 0.1
FNO_W = MIX_GROUP_W
FNO_GROUPS = 4
FNO_GROUP_CH = FNO_W // FNO_GROUPS

OFF_B = MLA_IN
OFF_C = MLA_IN + GQA_IN
OFF_D = OFF_C + SSM_W
IN_COLS = OFF_D + FNO_W
D_MIX = MLA_HEADS * MLA_V + GQA_HEADS * GQA_HD + SSM_W + FNO_W

N_EXPERTS = 16
N_EXPERT_GROUPS = 4
EXPERTS_PER_GROUP = N_EXPERTS // N_EXPERT_GROUPS
TOP_K = 2
D_EXPERT = D_MODEL // 2
EXPERT_BLOCK = 128

kernel_name = "hybrid_mla_gqa_s5_fnet_moe_dit"


def rmsnorm(x, g):
    xf = x.astype(jnp.float32)
    y = xf * lax.rsqrt(jnp.mean(xf * xf, axis=-1, keepdims=True) + RMS_EPS)
    return (y * g.astype(jnp.float32)).astype(x.dtype)


def modulate(h, shift, scale):
    return h * (1.0 + scale) + shift


def axial_rope_tables(row, col, dim):
    quarter = dim // 4
    inv_freq = ROPE_THETA ** (-jnp.arange(quarter, dtype=jnp.float32) / quarter)
    ang = jnp.concatenate([row[:, None] * inv_freq, col[:, None] * inv_freq], axis=-1)
    return jnp.cos(ang), jnp.sin(ang)


def apply_rope(x, rope):
    cos, sin = rope
    cos = cos[None, :, None, :]
    sin = sin[None, :, None, :]
    x1, x2 = jnp.split(x.astype(jnp.float32), 2, axis=-1)
    return jnp.concatenate([x1 * cos - x2 * sin, x2 * cos + x1 * sin], axis=-1).astype(x.dtype)


def block_attention(q, k, v):
    b, s, hq, dq = q.shape
    hk, dv = k.shape[2], v.shape[-1]
    g = hq // hk
    nb = s // Q_BLOCK
    qb = q.reshape(b, nb, Q_BLOCK, hk, g, dq).transpose(1, 0, 2, 3, 4, 5)
    scale = dq ** -0.5

    def one_block(qblk):
        sc = jnp.einsum('bqhgd,bnhd->bhgqn', qblk, k).astype(jnp.float32) * scale
        p = jax.nn.softmax(sc, axis=-1).astype(v.dtype)
        return jnp.einsum('bhgqn,bnhe->bqhge', p, v)

    o = lax.map(one_block, qb)
    return o.transpose(1, 0, 2, 3, 4, 5).reshape(b, s, hq * dv)


def mla_q(p, g_q, w_uq, rope):
    b, n, _ = p.shape
    q = (rmsnorm(p[..., :MLA_Q_RANK], g_q) @ w_uq).reshape(b, n, MLA_HEADS, MLA_NOPE + MLA_ROPE)
    if rope is not None:
        q = jnp.concatenate([q[..., :MLA_NOPE], apply_rope(q[..., MLA_NOPE:], rope)], axis=-1)
    return q


def mla_kv(p, g_kv, w_ukv, rope):
    b, n, _ = p.shape
    kv_lat = p[..., MLA_Q_RANK:MLA_Q_RANK + MLA_KV_RANK]
    k_rot = p[..., MLA_Q_RANK + MLA_KV_RANK:MLA_IN][:, :, None, :]
    kv = (rmsnorm(kv_lat, g_kv) @ w_ukv).reshape(b, n, MLA_HEADS, MLA_NOPE + MLA_V)
    k_nope, v = kv[..., :MLA_NOPE], kv[..., MLA_NOPE:]
    if rope is not None:
        k_rot = apply_rope(k_rot, rope)
    k = jnp.concatenate([k_nope, jnp.broadcast_to(k_rot, (b, n, MLA_HEADS, MLA_ROPE))], axis=-1)
    return k, v


def gqa_q(p, g_q, rope):
    b, n, _ = p.shape
    q = rmsnorm(p[..., :GQA_HEADS * GQA_HD].reshape(b, n, GQA_HEADS, GQA_HD), g_q)
    return apply_rope(q, rope) if rope is not None else q


def gqa_kv(p, g_k, rope):
    b, n, _ = p.shape
    k_end = (GQA_HEADS + GQA_KV_HEADS) * GQA_HD
    k = rmsnorm(p[..., GQA_HEADS * GQA_HD:k_end].reshape(b, n, GQA_KV_HEADS, GQA_HD), g_k)
    v = p[..., k_end:].reshape(b, n, GQA_KV_HEADS, GQA_HD)
    if rope is not None:
        k = apply_rope(k, rope)
    return k, v


def s5_discretise(lam_re, lam_im, log_dt, b_re, b_im):
    lam = lax.complex(lam_re.astype(jnp.float32), lam_im.astype(jnp.float32))
    dt = jnp.exp(log_dt.astype(jnp.float32))[:, None]
    lam_bar = jnp.exp(lam * dt)
    bmat = lax.complex(b_re.astype(jnp.float32), b_im.astype(jnp.float32))
    b_bar = ((lam_bar - 1.0) / lam)[..., None] * bmat
    return lam_bar, b_bar


def diag_scan(lam_bar, bu, reverse):
    a = jnp.broadcast_to(lam_bar, bu.shape)

    def combine(e1, e2):
        a1, b1 = e1
        a2, b2 = e2
        return a1 * a2, a2 * b1 + b2

    return lax.associative_scan(combine, (a, bu), reverse=reverse, axis=1)[1]


def s5_glu(y, w_glu, dtype):
    z = jax.nn.gelu(y).astype(dtype) @ w_glu
    a, b = jnp.split(z, 2, axis=-1)
    return a * jax.nn.sigmoid(b)


def s5_mixer(u_l, u_c, lam_re, lam_im, log_dt, b_re, b_im, c_re, c_im, d, w_glu, need_ctx):
    b, n, _ = u_l.shape
    ul = u_l.astype(jnp.float32).reshape(b, n, SSM_GROUPS, SSM_GROUP_CH).astype(jnp.complex64)
    uc = u_c.astype(jnp.float32).reshape(b, u_c.shape[1], SSM_GROUPS, SSM_GROUP_CH).astype(jnp.complex64)
    dg = d.astype(jnp.float32).reshape(SSM_GROUPS, SSM_GROUP_CH)
    y_l = dg * ul.real
    y_c = dg * uc.real if need_ctx else None
    for direction in range(2):
        reverse = direction == 1
        lam_bar, b_bar = s5_discretise(lam_re[direction], lam_im[direction], log_dt[direction],
                                       b_re[direction], b_im[direction])
        c_mat = lax.complex(c_re[direction].astype(jnp.float32), c_im[direction].astype(jnp.float32))
        h_c = diag_scan(lam_bar, jnp.einsum('bngh,gph->bngp', uc, b_bar), reverse)
        h_end = h_c[:, 0] if reverse else h_c[:, -1]
        bu_l = jnp.einsum('bngh,gph->bngp', ul, b_bar)
        bu_l = bu_l.at[:, -1 if reverse else 0].add(lam_bar * h_end)
        h_l = diag_scan(lam_bar, bu_l, reverse)
        y_l = y_l + jnp.einsum('bngp,ghp->bngh', h_l, c_mat).real
        if need_ctx:
            y_c = y_c + jnp.einsum('bngp,ghp->bngh', h_c, c_mat).real
    out_l = s5_glu(y_l.reshape(b, n, SSM_W), w_glu, u_l.dtype)
    out_c = s5_glu(y_c.reshape(b, -1, SSM_W), w_glu, u_c.dtype) if need_ctx else None
    return out_l, out_c


def fourier_mix(p):
    b, n, _ = p.shape
    f = p.astype(jnp.float32).reshape(b, n, FNO_GROUPS, FNO_GROUP_CH)
    return jnp.fft.fft2(f, axes=(1, 3), norm='ortho').real.reshape(b, n, FNO_W).astype(p.dtype)


def token_mixers(hl, hc, w_in, mla_q_norm_g, mla_w_uq, mla_kv_norm_g, mla_w_ukv,
                 gqa_q_norm_g, gqa_k_norm_g, ssm_lam_re, ssm_lam_im, ssm_log_dt,
                 ssm_b_re, ssm_b_im, ssm_c_re, ssm_c_im, ssm_d, ssm_w_glu,
                 rope_mla, rope_gqa, need_ctx):
    pl = hl @ w_in
    pc = hc @ (w_in if need_ctx else w_in[:, :OFF_D])
    pl_a, pl_b, pl_c, pl_d = pl[..., :OFF_B], pl[..., OFF_B:OFF_C], pl[..., OFF_C:OFF_D], pl[..., OFF_D:]
    pc_a, pc_b, pc_c = pc[..., :OFF_B], pc[..., OFF_B:OFF_C], pc[..., OFF_C:OFF_D]

    ka_c, va_c = mla_kv(pc_a, mla_kv_norm_g, mla_w_ukv, None)
    ka_l, va_l = mla_kv(pl_a, mla_kv_norm_g, mla_w_ukv, rope_mla)
    out_a = block_attention(mla_q(pl_a, mla_q_norm_g, mla_w_uq, rope_mla),
                            jnp.concatenate([ka_c, ka_l], axis=1), jnp.concatenate([va_c, va_l], axis=1))

    kb_c, vb_c = gqa_kv(pc_b, gqa_k_norm_g, None)
    kb_l, vb_l = gqa_kv(pl_b, gqa_k_norm_g, rope_gqa)
    out_b = block_attention(gqa_q(pl_b, gqa_q_norm_g, rope_gqa),
                            jnp.concatenate([kb_c, kb_l], axis=1), jnp.concatenate([vb_c, vb_l], axis=1))

    out_c_l, out_c_c = s5_mixer(pl_c, pc_c, ssm_lam_re, ssm_lam_im, ssm_log_dt, ssm_b_re, ssm_b_im,
                                ssm_c_re, ssm_c_im, ssm_d, ssm_w_glu, need_ctx)

    out_d = fourier_mix(pl_d)

    mix_l = jnp.concatenate([out_a, out_b, out_c_l, out_d], axis=-1)
    mix_c = None
    if need_ctx:
        ctx_a = block_attention(mla_q(pc_a, mla_q_norm_g, mla_w_uq, None), ka_c, va_c)
        ctx_b = block_attention(gqa_q(pc_b, gqa_q_norm_g, None), kb_c, vb_c)
        mix_c = jnp.concatenate([ctx_a, ctx_b, out_c_c, fourier_mix(pc[..., OFF_D:])], axis=-1)
    return mix_l, mix_c


def routed_moe(h, router_w, router_bias, w_gate, w_up, w_down):
    t, d = h.shape
    scores = jax.nn.sigmoid((h @ router_w).astype(jnp.float32))
    sel = (scores + router_bias.astype(jnp.float32)).reshape(t, N_EXPERT_GROUPS, EXPERTS_PER_GROUP)
    grp = jnp.argmax(lax.top_k(sel, TOP_K)[0].sum(-1), axis=-1)
    sel_in = jnp.take_along_axis(sel, grp[:, None, None], axis=1)[:, 0]
    _, local = lax.top_k(sel_in, TOP_K)
    expert = grp[:, None] * EXPERTS_PER_GROUP + local
    gate = jnp.take_along_axis(scores, expert, axis=1)
    gate = gate / jnp.sum(gate, axis=-1, keepdims=True)

    flat_e = expert.reshape(-1)
    flat_tok = jnp.repeat(jnp.arange(t, dtype=jnp.int32), TOP_K)
    flat_g = gate.reshape(-1)
    order = jnp.argsort(flat_e)
    e_sorted = flat_e[order]
    counts = jnp.bincount(flat_e, length=N_EXPERTS)
    padded = (counts + EXPERT_BLOCK - 1) // EXPERT_BLOCK * EXPERT_BLOCK
    pad_end = jnp.cumsum(padded)
    pad_start = pad_end - padded
    start = jnp.cumsum(counts) - counts
    dest = pad_start[e_sorted] + jnp.arange(t * TOP_K, dtype=jnp.int32) - start[e_sorted]
    n_blocks = (t * TOP_K + N_EXPERTS * (EXPERT_BLOCK - 1)) // EXPERT_BLOCK + 1
    n_rows = n_blocks * EXPERT_BLOCK
    row_tok = jnp.zeros((n_rows,), jnp.int32).at[dest].set(flat_tok[order])
    row_gate = jnp.zeros((n_rows,), jnp.float32).at[dest].set(flat_g[order])
    block_expert = jnp.minimum(
        jnp.searchsorted(pad_end, jnp.arange(n_blocks, dtype=jnp.int32) * EXPERT_BLOCK, side='right'),
        N_EXPERTS - 1)
    xb = h[row_tok].reshape(n_blocks, EXPERT_BLOCK, d)

    def expert_block(args):
        xblk, e = args
        return (jax.nn.silu(xblk @ w_gate[e]) * (xblk @ w_up[e])) @ w_down[e]

    yb = lax.map(expert_block, (xb, block_expert)).reshape(n_rows, d)
    return jnp.zeros_like(h).at[row_tok].add(yb * row_gate[:, None].astype(h.dtype))


def setup_inputs(seed: int = 0) -> dict:
    key = jax.random.key(seed)
    ks = jax.random.split(key, 31)
    f32 = jnp.float32

    def nrm(k, shape, std):
        return jax.random.normal(k, shape, f32) * std

    L, D = DEPTH, D_MODEL
    G, P, H = SSM_GROUPS, SSM_STATE, SSM_GROUP_CH
    return {
        'x': nrm(ks[0], (BATCH, SEQ, D), 1.0),
        'c': nrm(ks[1], (BATCH, D), 1.0),
        'ctx': nrm(ks[2], (BATCH, CTX_LEN, D), 1.0),
        'c_ctx': nrm(ks[3], (D,), 1.0),
        'ada_w': nrm(ks[4], (L, D, 6 * D), 0.5 * D ** -0.5),
        'ada_b': nrm(ks[5], (L, 6 * D), 0.02),
        'norm1_g': 1.0 + nrm(ks[6], (L, D), 0.02),
        'norm2_g': 1.0 + nrm(ks[7], (L, D), 0.02),
        'w_in': nrm(ks[8], (L, D, IN_COLS), D ** -0.5),
        'mla_q_norm_g': 1.0 + nrm(ks[9], (L, MLA_Q_RANK), 0.02),
        'mla_w_uq': nrm(ks[10], (L, MLA_Q_RANK, MLA_HEADS * (MLA_NOPE + MLA_ROPE)), MLA_Q_RANK ** -0.5),
        'mla_kv_norm_g': 1.0 + nrm(ks[11], (L, MLA_KV_RANK), 0.02),
        'mla_w_ukv': nrm(ks[12], (L, MLA_KV_RANK, MLA_HEADS * (MLA_NOPE + MLA_V)), MLA_KV_RANK ** -0.5),
        'gqa_q_norm_g': 1.0 + nrm(ks[13], (L, GQA_HD), 0.02),
        'gqa_k_norm_g': 1.0 + nrm(ks[14], (L, GQA_HD), 0.02),
        'ssm_lam_re': -0.5 + nrm(ks[15], (L, 2, G, P), 0.01),
        'ssm_lam_im': jnp.pi * jnp.arange(P, dtype=f32) + nrm(ks[16], (L, 2, G, P), 0.01),
        'ssm_log_dt': jax.random.uniform(ks[17], (L, 2, G), f32, math.log(SSM_DT_MIN), math.log(SSM_DT_MAX)),
        'ssm_b_re': nrm(ks[18], (L, 2, G, P, H), (2 * H) ** -0.5),
        'ssm_b_im': nrm(ks[19], (L, 2, G, P, H), (2 * H) ** -0.5),
        'ssm_c_re': nrm(ks[20], (L, 2, G, H, P), P ** -0.5),
        'ssm_c_im': nrm(ks[21], (L, 2, G, H, P), P ** -0.5),
        'ssm_d': nrm(ks[22], (L, SSM_W), 0.5),
        'ssm_w_glu': nrm(ks[23], (L, SSM_W, 2 * SSM_W), SSM_W ** -0.5),
        'w_out': nrm(ks[24], (L, D_MIX, D), D_MIX ** -0.5),
        'router_w': nrm(ks[25], (D, N_EXPERTS), D ** -0.5),
        'router_bias': nrm(ks[26], (N_EXPERTS,), 0.01),
        'moe_w_gate': nrm(ks[27], (L, N_EXPERTS, D, D_EXPERT), D ** -0.5),
        'moe_w_up': nrm(ks[28], (L, N_EXPERTS, D, D_EXPERT), D ** -0.5),
        'moe_w_down': nrm(ks[29], (L, N_EXPERTS, D_EXPERT, D), D_EXPERT ** -0.5),
        'final_norm_g': 1.0 + nrm(ks[30], (D,), 0.02),
    }


def reference(x, c, ctx, c_ctx, ada_w, ada_b, norm1_g, norm2_g, w_in, mla_q_norm_g, mla_w_uq,
              mla_kv_norm_g, mla_w_ukv, gqa_q_norm_g, gqa_k_norm_g, ssm_lam_re, ssm_lam_im,
              ssm_log_dt, ssm_b_re, ssm_b_im, ssm_c_re, ssm_c_im, ssm_d, ssm_w_glu, w_out,
              router_w, router_bias, moe_w_gate, moe_w_up, moe_w_down, final_norm_g):
    b, s, d = x.shape
    rows = s // GRID_W
    row = jnp.repeat(jnp.arange(rows), GRID_W).astype(jnp.float32)
    col = jnp.tile(jnp.arange(GRID_W), rows).astype(jnp.float32)
    rope_mla = axial_rope_tables(row, col, MLA_ROPE)
    rope_gqa = axial_rope_tables(row, col, GQA_HD)
    silu_c = jax.nn.silu(c)
    silu_cc = jax.nn.silu(c_ctx)

    for l in range(DEPTH):
        need_ctx = l < DEPTH - 1
        sh1, sc1, g1, sh2, sc2, g2 = [m[:, None, :] for m in jnp.split(silu_c @ ada_w[l] + ada_b[l], 6, axis=-1)]
        csh1, csc1, cg1, csh2, csc2, cg2 = jnp.split(silu_cc @ ada_w[l] + ada_b[l], 6, axis=-1)

        hl = modulate(rmsnorm(x, norm1_g[l]), sh1, sc1)
        hc = modulate(rmsnorm(ctx, norm1_g[l]), csh1, csc1)
        mix_l, mix_c = token_mixers(hl, hc, w_in[l], mla_q_norm_g[l], mla_w_uq[l], mla_kv_norm_g[l],
                                    mla_w_ukv[l], gqa_q_norm_g[l], gqa_k_norm_g[l], ssm_lam_re[l],
                                    ssm_lam_im[l], ssm_log_dt[l], ssm_b_re[l], ssm_b_im[l], ssm_c_re[l],
                                    ssm_c_im[l], ssm_d[l], ssm_w_glu[l], rope_mla, rope_gqa, need_ctx)
        x = x + g1 * (mix_l @ w_out[l])
        hl2 = modulate(rmsnorm(x, norm2_g[l]), sh2, sc2)
        if need_ctx:
            ctx = ctx + cg1 * (mix_c @ w_out[l])
            hc2 = modulate(rmsnorm(ctx, norm2_g[l]), csh2, csc2)
            n_ctx = hc2.shape[0] * hc2.shape[1]
            tokens = jnp.concatenate([hc2.reshape(-1, d), hl2.reshape(-1, d)], axis=0)
            y = routed_moe(tokens, router_w, router_bias, moe_w_gate[l], moe_w_up[l], moe_w_down[l])
            ctx = ctx + cg2 * y[:n_ctx].reshape(ctx.shape)
            x = x + g2 * y[n_ctx:].reshape(x.shape)
        else:
            y = routed_moe(hl2.reshape(-1, d), router_w, router_bias, moe_w_gate[l], moe_w_up[l], moe_w_down[l])
            x = x + g2 * y.reshape(x.shape)

    return rmsnorm(x, final_norm_g)
```

```cpp
#include <hip/hip_runtime.h>
#include <cstdio>
#include <cstdint>

#ifndef MK_MULTI
#define MK_MULTI 0
#endif
#ifndef DBG_STOP
#define DBG_STOP 0
#endif
#ifndef DBG_TAP
#define DBG_TAP 0
#endif
#ifndef GEMM_OLDOFF
#define GEMM_OLDOFF 1
#endif
#ifndef DBG_SKIP
#define DBG_SKIP 0
#endif
#ifndef PROBE_PHASE
#define PROBE_PHASE -1
#endif
#ifndef PROBE_SUB
#define PROBE_SUB -1
#endif
#ifndef PROBE_DRY
#define PROBE_DRY 0
#endif
#ifndef DBG_REP
#define DBG_REP 0
#endif

typedef unsigned short bf16_t;
typedef short bf16x8 __attribute__((ext_vector_type(8)));
typedef short s16x4 __attribute__((ext_vector_type(4)));
typedef float f32x4 __attribute__((ext_vector_type(4)));
typedef float f32x16 __attribute__((ext_vector_type(16)));
typedef unsigned u32x4 __attribute__((ext_vector_type(4)));
typedef unsigned u32x2 __attribute__((ext_vector_type(2)));

constexpr int DM = 2048, NBATCH = 2, SEQ = 16384, CTX = 256, NTOK = SEQ + CTX, MR = NBATCH * NTOK;
constexpr int INC = 2624, OFF_B = 576, OFF_C = 1600, OFF_D = 2112, INCP = 2816;
constexpr int NEXP = 16, DEXP = 1024;
constexpr int NCHUNK = NTOK / 64;
constexpr float RMS_EPS = 1e-6f;
constexpr int NTHREADS = 512;
constexpr int LDS_BYTES = 147456;
constexpr int ACT_ROWS = 2 * MR + NEXP * 256;

constexpr size_t al256(size_t x) { return (x + 255) & ~size_t(255); }
constexpr size_t WS_CTL = 0, CTL_BYTES = 32768;
constexpr size_t WS_MOD = CTL_BYTES;
constexpr size_t WS_TW = WS_MOD + al256(2 * 3 * 12288 * 4);
constexpr size_t WS_S5LAM = WS_TW + 65536;
constexpr size_t WS_S5BM = WS_S5LAM + 2 * 2 * 32 * 64 * 16;
constexpr size_t WS_S5CM = WS_S5BM + 2 * 2 * 32 * 128 * 16 * 2;
constexpr size_t WS_BTIN = WS_S5CM + 2 * 32 * 16 * 256 * 2;
constexpr size_t WS_BTUQ = WS_BTIN + (size_t)2 * INCP * 2048 * 2;
constexpr size_t WS_BTUKV = WS_BTUQ + (size_t)2 * 768 * 384 * 2;
constexpr size_t WS_BTGLU = WS_BTUKV + (size_t)2 * 1024 * 256 * 2;
constexpr size_t WS_BTOUT = WS_BTGLU + (size_t)2 * 1024 * 512 * 2;
constexpr size_t WS_BTGU = WS_BTOUT + (size_t)2 * 2048 * 2048 * 2;
constexpr size_t WS_BTDN = WS_BTGU + (size_t)2 * 16 * 2048 * 2048 * 2;
constexpr size_t WS_HL = WS_BTDN + (size_t)2 * 16 * 2048 * 1024 * 2;
constexpr size_t WS_CTXX = WS_HL + (size_t)MR * 2048 * 2;
constexpr size_t WS_GATE = WS_CTXX + (size_t)512 * 2048 * 4;
constexpr size_t WS_LIST = WS_GATE + al256((size_t)MR * 2 * 4);
constexpr size_t WS_R = WS_LIST + al256((size_t)16 * MR * 4);
constexpr size_t WS_PL = WS_R;
constexpr size_t WS_A2 = WS_PL + (size_t)MR * INC * 2;
constexpr size_t WS_QM = WS_A2 + (size_t)MR * 640 * 2;
constexpr size_t WS_KM = WS_QM + (size_t)MR * 768 * 2;
constexpr size_t WS_VM = WS_KM + (size_t)MR * 768 * 2;
constexpr size_t WS_MIX = WS_VM + (size_t)MR * 512 * 2;
constexpr size_t WS_S5E = WS_MIX + (size_t)MR * 2048 * 2;
constexpr size_t WS_S5H = WS_S5E + (size_t)2 * 2 * 32 * NCHUNK * 128 * 4;
constexpr size_t WS_YB = WS_S5H + (size_t)2 * 2 * 32 * NCHUNK * 128 * 4;
constexpr size_t WS_GT = WS_YB + (size_t)MR * 512 * 2;
constexpr size_t WS_OT = WS_GT + (size_t)NBATCH * 4 * 64 * NTOK * 4;
constexpr size_t WS_K8M = WS_OT + (size_t)NBATCH * 4 * 128 * NTOK * 2;
constexpr size_t WS_VTM = WS_K8M + (size_t)MR * 768;
constexpr size_t WS_K8G = WS_VTM + (size_t)NBATCH * 4 * NCHUNK * 8192;
constexpr size_t WS_VTG = WS_K8G + (size_t)MR * 256;
constexpr size_t WS_END1 = WS_VTG + (size_t)NBATCH * 2 * NCHUNK * 8192;
constexpr size_t WS_ACT = WS_R;
constexpr size_t WS_Y = WS_ACT + al256((size_t)ACT_ROWS * 1024 * 2);
constexpr size_t WS_END2 = WS_Y + (size_t)MR * 2 * 2048 * 2;
constexpr size_t WS_END = WS_END1 > WS_END2 ? WS_END1 : WS_END2;
constexpr size_t WS_DRY = WS_END2;
static_assert(WS_DRY + (size_t)NTOK * 2048 * 4 <= WS_END1, "dry-run area");

constexpr int CW_CNT = 4096;

struct Params {
    const float* in[31];
    float* out;
    unsigned char* ws;
    int ph_lo, ph_hi;
    int sub, dry;
};
typedef const Params __attribute__((address_space(4)))* CP;

typedef float f32x2 __attribute__((ext_vector_type(2)));
typedef __bf16 bf16x2_t __attribute__((ext_vector_type(2)));
__device__ __forceinline__ unsigned cvtpk(float lo, float hi) { f32x2 f = {lo, hi}; bf16x2_t v = __builtin_convertvector(f, bf16x2_t); return __builtin_bit_cast(unsigned, v); }
__device__ __forceinline__ bf16_t f2bf(float x) { return (bf16_t)(cvtpk(x, x) & 0xffffu); }
typedef int i32x8 __attribute__((ext_vector_type(8)));
typedef int i32x4 __attribute__((ext_vector_type(4)));
__device__ __forceinline__ unsigned f2f8x4(float a, float b, float c, float d) { int w = __builtin_amdgcn_cvt_pk_fp8_f32(a, b, 0, false); return (unsigned)__builtin_amdgcn_cvt_pk_fp8_f32(c, d, w, true); }
__device__ __forceinline__ unsigned char f2f8(float a) { return (unsigned char)(__builtin_amdgcn_cvt_pk_fp8_f32(a, a, 0, false) & 0xff); }
__device__ __forceinline__ int vt_pos(int k) { const int blk = k >> 5, kk = k & 31; return 32 * ((kk >> 2) & 1) + 16 * blk + (kk & 3) + 4 * (kk >> 3); }
__device__ __forceinline__ float bf2f(bf16_t u) { return __uint_as_float(((unsigned)u) << 16); }
__device__ __forceinline__ float bflo(unsigned w) { return __uint_as_float(w << 16); }
__device__ __forceinline__ float bfhi(unsigned w) { return __uint_as_float(w & 0xffff0000u); }
template <int K> __device__ __forceinline__ float swz_xor(float v) { return __int_as_float(__builtin_amdgcn_ds_swizzle(__float_as_int(v), (K << 10) | 0x1f)); }
__device__ __forceinline__ float half_sum(float v) { auto r = __builtin_amdgcn_permlane32_swap(__float_as_uint(v), __float_as_uint(v), false, false); return __uint_as_float(r[0]) + __uint_as_float(r[1]); }
__device__ __forceinline__ float half_other(float v, bool lo) { auto r = __builtin_amdgcn_permlane32_swap(__float_as_uint(v), __float_as_uint(v), false, false); return __uint_as_float(lo ? r[1] : r[0]); }
__device__ __forceinline__ float wave_sum(float v) {
    v += swz_xor<16>(v); v += swz_xor<8>(v); v += swz_xor<4>(v); v += swz_xor<2>(v); v += swz_xor<1>(v);
    return half_sum(v);
}
__device__ __forceinline__ int otid() { int t = threadIdx.x; asm volatile("" : "+v"(t)); return t; }
__device__ __forceinline__ int obid() { int b = blockIdx.x; asm volatile("" : "+s"(b)); return b; }
__device__ __forceinline__ void st_wt(float* p, float v) { __hip_atomic_store(p, v, __ATOMIC_RELAXED, __HIP_MEMORY_SCOPE_AGENT); }
__device__ __forceinline__ void st_wt(int* p, int v) { __hip_atomic_store(p, v, __ATOMIC_RELAXED, __HIP_MEMORY_SCOPE_AGENT); }
__device__ __forceinline__ void st_wt(unsigned* p, unsigned v) { __hip_atomic_store(p, v, __ATOMIC_RELAXED, __HIP_MEMORY_SCOPE_AGENT); }
__device__ __forceinline__ float silu_f(float x) { return x / (1.f + expf(-x)); }
__device__ __forceinline__ float sigmoid_f(float x) { return 1.f / (1.f + expf(-x)); }
__device__ __forceinline__ float sigmoid_hw(float x) { return __builtin_amdgcn_rcpf(1.f + __builtin_amdgcn_exp2f(-1.4426950408889634f * x)); }
__device__ __forceinline__ float silu_hw(float x) { return x * sigmoid_hw(x); }

#define XB_TMO      128
#define XB_XCNT(j)  (256  + 64 * (j))
#define XB_XSUB(j)  (1280 + 64 * (j))
#define XB_XGEN(j)  (2304 + 64 * (j))
#define XB_TOP      3328
#define XB_TOPGEN   3392
#define XCD_BAR_WORDS 3456
#define XB_SPIN_CAP (1u << 18)
#define LAS __attribute__((address_space(3)))

__device__ __forceinline__ unsigned xb_ld(unsigned* p)              { return __hip_atomic_load(p, __ATOMIC_RELAXED, __HIP_MEMORY_SCOPE_AGENT); }
__device__ __forceinline__ unsigned xb_add(unsigned* p, unsigned v) { return __hip_atomic_fetch_add(p, v, __ATOMIC_RELAXED, __HIP_MEMORY_SCOPE_AGENT); }
__device__ __forceinline__ unsigned xb_xcc_id() { return (unsigned)__builtin_amdgcn_s_getreg((3 << 11) | 20) & 0xFu; }
#define XB_SPIN(cond, bar) do { unsigned _sp = 0; while (cond) { __builtin_amdgcn_s_sleep(1); \
    if ((++_sp & 255u) == 0u) { if (xb_ld(&(bar)[XB_TMO])) break; if (_sp > XB_SPIN_CAP) { atomicAdd(&(bar)[XB_TMO], 1u); break; } } } } while (0)

struct XcdBarrier { unsigned* bar; unsigned x; volatile LAS unsigned* st; };

__device__ __forceinline__ XcdBarrier xcd_barrier_post(unsigned* bar, volatile LAS unsigned* st) {
    XcdBarrier b; b.bar = bar; b.x = xb_xcc_id(); b.st = st;
    if (threadIdx.x == 0) (void)xb_add(&bar[XB_XCNT(b.x)], 1u);
    return b;
}
__device__ __forceinline__ void xcd_barrier_complete(unsigned* bar, unsigned x, unsigned& nloc, unsigned& nx) {
    const unsigned G = gridDim.x * gridDim.y * gridDim.z;
    unsigned sum, cnt, mine, sp = 0u;
    for (;;) {
        sum = 0u; cnt = 0u; mine = 0u;
#pragma unroll
        for (unsigned j = 0; j < 16; ++j) { const unsigned c = xb_ld(&bar[XB_XCNT(j)]); sum += c; cnt += (c > 0u) ? 1u : 0u; mine = (j == x) ? c : mine; }
        if (sum == G) break;
        __builtin_amdgcn_s_sleep(1);
        if ((++sp & 255u) == 0u) { if (xb_ld(&bar[XB_TMO])) break; if (sp > XB_SPIN_CAP) { atomicAdd(&bar[XB_TMO], 1u); break; } }
    }
    nloc = mine > 0u ? mine : 1u; nx = cnt > 0u ? cnt : 1u;
}
__device__ __noinline__ void xcd_barrier_impl(unsigned* bar_, unsigned x_, volatile LAS unsigned* st_) {
    XcdBarrier b; b.bar = bar_; b.x = x_; b.st = st_;
    asm volatile("s_waitcnt vmcnt(0)" ::: "memory");
    __syncthreads();
    if (threadIdx.x == 0) {
        unsigned* bar = b.bar;
        __builtin_amdgcn_s_waitcnt(0);
        unsigned nloc = b.st[0], nx = b.st[1];
        if (nloc == 0u) { xcd_barrier_complete(bar, b.x, nloc, nx); b.st[0] = nloc; b.st[1] = nx; }
        const unsigned old = xb_add(&bar[XB_XSUB(b.x)], 1u);
        const unsigned gen = old / nloc;
        if (old + 1u == (gen + 1u) * nloc) {
            __builtin_amdgcn_fence(__ATOMIC_RELEASE, "agent");
            asm volatile("s_waitcnt vmcnt(0)" ::: "memory");
            const unsigned og = xb_add(&bar[XB_TOP], 1u);
            const unsigned tg = og / nx;
            if (og + 1u == (tg + 1u) * nx) xb_add(&bar[XB_TOPGEN], 1u);
            else XB_SPIN(xb_ld(&bar[XB_TOPGEN]) == tg, bar);
            __builtin_amdgcn_fence(__ATOMIC_ACQUIRE, "agent");
            xb_add(&bar[XB_XGEN(b.x)], 1u);
            asm volatile("s_waitcnt vmcnt(0)" ::: "memory");
        } else {
            XB_SPIN(xb_ld(&bar[XB_XGEN(b.x)]) == gen, bar);
            __builtin_amdgcn_fence(__ATOMIC_ACQUIRE, "agent");
            asm volatile("s_waitcnt vmcnt(0)" ::: "memory");
        }
    }
    __syncthreads();
}
__device__ __forceinline__ void xcd_barrier(const XcdBarrier& b) { xcd_barrier_impl(b.bar, b.x, b.st); }

constexpr int G_BK = 64, G_HT = 128 * 64;
__device__ __forceinline__ int lds_byte(int r, int c) { int st = (r >> 4) * 2 + (c >> 5), rr = r & 15, cc = c & 31, ob = rr * 64 + cc * 2; return st * 1024 + (ob ^ (((ob >> 9) & 1) << 5)); }
__device__ __forceinline__ void stage_rc(int b, int& R, int& C) { int st = b / 1024, sb = b % 1024, swz = sb ^ (((sb >> 9) & 1) << 5); R = (st >> 1) * 16 + swz / 64; C = (st & 1) * 32 + (swz % 64) / 2; }

template <bool GATHER, int LDA, bool F8, int SCM, class Epi>
__device__ __forceinline__ void gemm_unit(const bf16_t* __restrict__ A, const int (&aoff)[2][2], const bf16_t* __restrict__ Bt, int boff0, int ldb, int K, char* lds, const Epi& epi) {
    bf16_t* shm = (bf16_t*)lds;
#define SA(b, h) (shm + ((b) * 2 + (h)) * G_HT)
#define SB(b, h) (shm + (4 + (b) * 2 + (h)) * G_HT)
#define STAGE_A(P, h, kt) do { \
    __builtin_amdgcn_global_load_lds((const unsigned*)(A + ((GATHER || GEMM_OLDOFF) ? (long)aoff[h][0] : (long)aoff[0][0] + (long)((h) * 128) * LDA) + (long)(kt) * G_BK), (unsigned*)((char*)(P) + tz * 16), 16, 0, 0); \
    __builtin_amdgcn_global_load_lds((const unsigned*)(A + ((GATHER || GEMM_OLDOFF) ? (long)aoff[h][1] : (long)aoff[0][0] + (long)((h) * 128 + 64) * LDA) + (long)(kt) * G_BK), (unsigned*)((char*)(P) + tz * 16 + 8192), 16, 0, 0); } while (0)
#define STAGE_B(P, h, kt) do { \
    __builtin_amdgcn_global_load_lds((const unsigned*)(Bt + (long)boff0 + (long)((h) * 128) * ldb + (long)(kt) * G_BK), (unsigned*)((char*)(P) + tz * 16), 16, 0, 0); \
    __builtin_amdgcn_global_load_lds((const unsigned*)(Bt + (long)boff0 + (long)((h) * 128 + 64) * ldb + (long)(kt) * G_BK), (unsigned*)((char*)(P) + tz * 16 + 8192), 16, 0, 0); } while (0)
#define LDA(dst, b, h) do { if constexpr (F8) { _Pragma("unroll") for (int m = 0; m < 4; ++m) { \
      const i32x4 lo_ = *reinterpret_cast<const i32x4*>((char*)SA(b, h) + lds_byte(wr * 64 + m * 16 + fr, fq * 8)), hi_ = *reinterpret_cast<const i32x4*>((char*)SA(b, h) + lds_byte(wr * 64 + m * 16 + fr, 32 + fq * 8)); \
      dst##8[m] = __builtin_shufflevector(lo_, hi_, 0, 1, 2, 3, 4, 5, 6, 7); } } \
    else { _Pragma("unroll") for (int m = 0; m < 4; ++m) _Pragma("unroll") for (int k = 0; k < 2; ++k) \
      dst[m][k] = *reinterpret_cast<const bf16x8*>((char*)SA(b, h) + lds_byte(wr * 64 + m * 16 + fr, k * 32 + fq * 8)); } } while (0)
#define LDB(dst, b, h) do { if constexpr (F8) { _Pragma("unroll") for (int n = 0; n < 2; ++n) { \
      const i32x4 lo_ = *reinterpret_cast<const i32x4*>((char*)SB(b, h) + lds_byte(wc * 32 + n * 16 + fr, fq * 8)), hi_ = *reinterpret_cast<const i32x4*>((char*)SB(b, h) + lds_byte(wc * 32 + n * 16 + fr, 32 + fq * 8)); \
      dst##8[n] = __builtin_shufflevector(lo_, hi_, 0, 1, 2, 3, 4, 5, 6, 7); } } \
    else { _Pragma("unroll") for (int n = 0; n < 2; ++n) _Pragma("unroll") for (int k = 0; k < 2; ++k) \
      dst[n][k] = *reinterpret_cast<const bf16x8*>((char*)SB(b, h) + lds_byte(wc * 32 + n * 16 + fr, k * 32 + fq * 8)); } } while (0)
#define MMA(ai, bj, At, Bv) do { __builtin_amdgcn_s_setprio(1); \
    if constexpr (F8) { _Pragma("unroll") for (int m = 0; m < 4; ++m) _Pragma("unroll") for (int n = 0; n < 2; ++n) \
        { acc[ai][bj][m][n] = __builtin_amdgcn_mfma_scale_f32_16x16x128_f8f6f4(Bv##8[n], At##8[m], acc[ai][bj][m][n], 0, 0, 0, 0x7f7f7f7f, 0, sc_b); \
          asm volatile("" : "+v"(acc[ai][bj][m][n])); } }   \
    else { _Pragma("unroll") for (int m = 0; m < 4; ++m) _Pragma("unroll") for (int n = 0; n < 2; ++n) _Pragma("unroll") for (int k = 0; k < 2; ++k) \
      acc[ai][bj][m][n] = __builtin_amdgcn_mfma_f32_16x16x32_bf16(Bv[n][k], At[m][k], acc[ai][bj][m][n], 0, 0, 0); } \
    __builtin_amdgcn_s_setprio(0); } while (0)
#define WAIT_V(n) asm volatile("s_waitcnt vmcnt(" #n ")" ::: "memory")
#define WAIT_L(n) asm volatile("s_waitcnt lgkmcnt(" #n ")" ::: "memory")
#define BAR __builtin_amdgcn_s_barrier()
#define SCHED __builtin_amdgcn_sched_barrier(0)
    int tz = threadIdx.x; asm volatile("" : "+v"(tz));
    int wid = tz >> 6, lane = tz & 63, wr = wid >> 2, wc = wid & 3, fr = lane & 15, fq = lane >> 4;
    f32x4 acc[2][2][4][2];
#pragma unroll
    for (int a = 0; a < 2; ++a)
#pragma unroll
        for (int b = 0; b < 2; ++b)
#pragma unroll
            for (int m = 0; m < 4; ++m)
#pragma unroll
                for (int n = 0; n < 2; ++n) acc[a][b][m][n] = (f32x4){0.f, 0.f, 0.f, 0.f};
#define ASC(kt) (SCM == 0 ? 0x7f7f7f7f : ((kt) < 8 ? 0x7a7a7a7a : ((kt) >= 12 ? (int)0x81818181 : 0x7f7f7f7f)))
    int sc_b = 0x7f7f7f7f;
    bf16x8 At[4][2], B0[2][2], B1[2][2]; i32x8 At8[4], B08[2], B18[2];
    const int nt = K / G_BK;
    STAGE_B(SB(0, 0), 0, 0); STAGE_A(SA(0, 0), 0, 0);
    STAGE_B(SB(0, 1), 1, 0); STAGE_A(SA(0, 1), 1, 0);
    if (wr == 1) BAR;
    WAIT_V(4); BAR;
    STAGE_B(SB(1, 0), 0, 1); STAGE_A(SA(1, 0), 0, 1); STAGE_B(SB(1, 1), 1, 1);
    WAIT_V(6); BAR;
    for (int t = 0; t < nt - 2; t += 2) {
        sc_b = ASC(t);
        LDB(B0, 0, 0); SCHED; LDA(At, 0, 0); STAGE_A(SA(1, 1), 1, t + 1);
        WAIT_L(8); BAR; WAIT_L(0); MMA(0, 0, At, B0); BAR; SCHED;
        LDB(B1, 0, 1); STAGE_B(SB(0, 0), 0, t + 2);
        BAR; WAIT_L(0); MMA(0, 1, At, B1); BAR;
        LDA(At, 0, 1); STAGE_A(SA(0, 0), 0, t + 2);
        BAR; WAIT_L(0); MMA(1, 0, At, B0); BAR; SCHED;
        STAGE_B(SB(0, 1), 1, t + 2);
        WAIT_V(6); BAR; MMA(1, 1, At, B1); BAR;
        sc_b = ASC(t + 1);
        LDB(B0, 1, 0); SCHED; LDA(At, 1, 0); STAGE_A(SA(0, 1), 1, t + 2);
        WAIT_L(8); BAR; WAIT_L(0); MMA(0, 0, At, B0); BAR; SCHED;
        LDB(B1, 1, 1); STAGE_B(SB(1, 0), 0, t + 3);
        BAR; WAIT_L(0); MMA(0, 1, At, B1); BAR;
        LDA(At, 1, 1); STAGE_A(SA(1, 0), 0, t + 3);
        BAR; WAIT_L(0); MMA(1, 0, At, B0); BAR; SCHED;
        STAGE_B(SB(1, 1), 1, t + 3);
        WAIT_V(6); BAR; MMA(1, 1, At, B1); BAR;
    }
    tz = threadIdx.x; asm volatile("" : "+v"(tz)); wid = tz >> 6; lane = tz & 63; wr = wid >> 2; wc = wid & 3; fr = lane & 15; fq = lane >> 4;
    sc_b = ASC(nt - 2);
    { LDB(B0, 0, 0); WAIT_V(0); LDA(At, 0, 0); STAGE_A(SA(1, 1), 1, nt - 1);
      BAR; WAIT_L(0); MMA(0, 0, At, B0); BAR;
      LDB(B1, 0, 1); BAR; WAIT_L(0); MMA(0, 1, At, B1); BAR;
      LDA(At, 0, 1); WAIT_V(4); BAR; WAIT_L(0); MMA(1, 0, At, B0); MMA(1, 1, At, B1); BAR; }
    sc_b = ASC(nt - 1);
    { LDB(B0, 1, 0); LDA(At, 1, 0); WAIT_V(2); BAR; WAIT_L(0); MMA(0, 0, At, B0); BAR;
      LDB(B1, 1, 1); WAIT_V(0); BAR; WAIT_L(0); MMA(0, 1, At, B1); BAR;
      LDA(At, 1, 1); BAR; WAIT_L(0); MMA(1, 0, At, B0); MMA(1, 1, At, B1); BAR; }
    if (wr == 0) BAR;
    if constexpr (F8) {
#pragma unroll
        for (int a = 0; a < 2; ++a)
#pragma unroll
            for (int b = 0; b < 2; ++b)
#pragma unroll
                for (int m = 0; m < 4; ++m)
#pragma unroll
                    for (int n = 0; n < 2; ++n) asm volatile("" : "+v"(acc[a][b][m][n]));
    }
    epi(acc, wr, wc, fr, fq);
    __syncthreads();
#undef SA
#undef SB
#undef STAGE_A
#undef STAGE_B
#undef LDA
#undef LDB
#undef MMA
#undef ASC
}
__device__ __forceinline__ void stage_coords(int& R0, int& C0) { stage_rc(otid() * 16, R0, C0); }

constexpr int A_KVBLK = 64;
constexpr size_t A_SHM_V = 64 * 128 * 2;
#define SBAR() __builtin_amdgcn_sched_barrier(0)
__device__ __forceinline__ int crow(int r, int hi) { return (r & 3) + 8 * (r >> 2) + 4 * hi; }
template <int DQK> __device__ __forceinline__ int kswz(int row, int colB) { return row * (DQK * 2) + (colB ^ ((row & 7) << 4)); }

template <int DQK>
__device__ __forceinline__ void partialSM(f32x16& p0, f32x16& p1, float& m_reg, float& mn, float& alpha) {
    constexpr float SCALE = (DQK == 128) ? 0.088388347648318440f : 0.072168783648703220f;
    constexpr float C = SCALE * 1.4426950408889634f;
    constexpr float THR = 8.f;
    float pmax = p0[0];
#pragma unroll
    for (int r = 1; r < 16; ++r) pmax = fmaxf(pmax, p0[r]);
#pragma unroll
    for (int r = 0; r < 16; ++r) pmax = fmaxf(pmax, p1[r]);
    { auto rr = __builtin_amdgcn_permlane32_swap(__float_as_uint(pmax), __float_as_uint(pmax), false, false);
      pmax = fmaxf(__uint_as_float(rr[0]), __uint_as_float(rr[1])); }
    if (__builtin_expect(__all(pmax - m_reg <= THR / SCALE), 1)) { mn = m_reg; alpha = 1.f; }
    else { mn = fmaxf(m_reg, pmax); alpha = __builtin_amdgcn_exp2f((m_reg - mn) * C); m_reg = mn; }
    float mnC = -mn * C;
#pragma unroll
    for (int r = 0; r < 16; ++r) p0[r] = fmaf(p0[r], C, mnC);
#pragma unroll
    for (int r = 0; r < 16; ++r) p1[r] = fmaf(p1[r], C, mnC);
#pragma unroll
    for (int r = 0; r < 16; ++r) p0[r] = __builtin_amdgcn_exp2f(p0[r]);
}
__device__ __forceinline__ void finishSM(f32x16& p0, f32x16& p1, float alpha, float& l_reg, bf16x8& pa0, bf16x8& pa1, bf16x8& pa2, bf16x8& pa3) {
#pragma unroll
    for (int r = 0; r < 16; ++r) p1[r] = __builtin_amdgcn_exp2f(p1[r]);
    float ps = 0;
#pragma unroll
    for (int r = 0; r < 16; ++r) ps += p0[r];
#pragma unroll
    for (int r = 0; r < 16; ++r) ps += p1[r];
    { auto rr = __builtin_amdgcn_permlane32_swap(__float_as_uint(ps), __float_as_uint(ps), false, false);
      ps = __uint_as_float(rr[0]) + __uint_as_float(rr[1]); }
    l_reg = l_reg * alpha + ps;
#define PK4(P, BASE, OUT) do { unsigned a0 = cvtpk(P[BASE + 0], P[BASE + 1]), a1 = cvtpk(P[BASE + 2], P[BASE + 3]);   \
    unsigned b0 = cvtpk(P[BASE + 4], P[BASE + 5]), b1 = cvtpk(P[BASE + 6], P[BASE + 7]);                              \
    auto r0 = __builtin_amdgcn_permlane32_swap(a0, b0, false, false); auto r1 = __builtin_amdgcn_permlane32_swap(a1, b1, false, false); \
    u32x4 w = {r0[0], r1[0], r0[1], r1[1]}; OUT = *reinterpret_cast<bf16x8*>(&w); } while (0)
    PK4(p0, 0, pa0); PK4(p0, 8, pa1); PK4(p1, 0, pa2); PK4(p1, 8, pa3);
#undef PK4
}
template <int DQK>
__device__ __forceinline__ void qkt(f32x16& p0, f32x16& p1, const char* Ks, const bf16x8* qr, int r32, int hi) {
    p0 = f32x16{}; p1 = f32x16{};
#pragma unroll
    for (int d0 = 0; d0 < DQK / 16; ++d0) { int cb = (d0 * 16 + hi * 8) * 2;
        bf16x8 b0 = *reinterpret_cast<const bf16x8*>(Ks + kswz<DQK>(r32, cb));
        bf16x8 b1 = *reinterpret_cast<const bf16x8*>(Ks + kswz<DQK>(32 + r32, cb));
        p0 = __builtin_amdgcn_mfma_f32_32x32x16_bf16(b0, qr[d0], p0, 0, 0, 0);
        p1 = __builtin_amdgcn_mfma_f32_32x32x16_bf16(b1, qr[d0], p1, 0, 0, 0); }
}
__device__ __forceinline__ int v_st(int k, int c) { const int kk = (k & ~0xC) | ((k & 4) << 1) | ((k & 8) >> 1); return ((kk >> 3) * 4 + (c >> 5)) * 512 + ((kk & 7) * 32 + (c & 31)) * 2; }
__device__ __forceinline__ int v_rd_base(int lane) { return ((lane & 3) << 3) | (((lane >> 2) & 3) << 6) | (((lane >> 4) & 1) << 5) | (((lane >> 5) & 1) << 8); }
constexpr int v_rd_off(int d0, int ks, int half) { return d0 * 512 + ks * 4096 + half * 2048; }
template <int OFF> __device__ __forceinline__ s16x4 tr_read(int vb) {
    s16x4 r; asm volatile("ds_read_b64_tr_b16 %0, %1 offset:%2" : "=&v"(r) : "v"(vb), "i"(OFF) : "memory"); return r;
}
template <int D0> __device__ __forceinline__ void pv_one(f32x16& od, int vb, bf16x8 pa0, bf16x8 pa1, bf16x8 pa2, bf16x8 pa3) {
    const s16x4 l0 = tr_read<v_rd_off(D0, 0, 0)>(vb), h0 = tr_read<v_rd_off(D0, 0, 1)>(vb), l1 = tr_read<v_rd_off(D0, 1, 0)>(vb), h1 = tr_read<v_rd_off(D0, 1, 1)>(vb);
    const s16x4 l2 = tr_read<v_rd_off(D0, 2, 0)>(vb), h2 = tr_read<v_rd_off(D0, 2, 1)>(vb), l3 = tr_read<v_rd_off(D0, 3, 0)>(vb), h3 = tr_read<v_rd_off(D0, 3, 1)>(vb);
    asm volatile("s_waitcnt lgkmcnt(0)" ::: "memory"); SBAR();
#define PKV(L, H) (bf16x8){L[0], L[1], L[2], L[3], H[0], H[1], H[2], H[3]}
    od = __builtin_amdgcn_mfma_f32_32x32x16_bf16(pa0, PKV(l0, h0), od, 0, 0, 0);
    od = __builtin_amdgcn_mfma_f32_32x32x16_bf16(pa1, PKV(l1, h1), od, 0, 0, 0);
    od = __builtin_amdgcn_mfma_f32_32x32x16_bf16(pa2, PKV(l2, h2), od, 0, 0, 0);
    od = __builtin_amdgcn_mfma_f32_32x32x16_bf16(pa3, PKV(l3, h3), od, 0, 0, 0);
#undef PKV
}
__device__ __forceinline__ void pv_d0(f32x16* o, int vb, bf16x8 pa0, bf16x8 pa1, bf16x8 pa2, bf16x8 pa3) {
    pv_one<0>(o[0], vb, pa0, pa1, pa2, pa3); pv_one<1>(o[1], vb, pa0, pa1, pa2, pa3); pv_one<2>(o[2], vb, pa0, pa1, pa2, pa3); pv_one<3>(o[3], vb, pa0, pa1, pa2, pa3);
}

template <int DQK, bool ROPEQ, int ldq, int ldk, int ldv, int ldo>
__device__ __forceinline__ void attn_unit(const bf16_t* __restrict__ Qb, const bf16_t* __restrict__ Kh, const bf16_t* __restrict__ Vh,
                                          bf16_t* __restrict__ Ob, int seq, int s0, bool do_rope, char* lds) {
    constexpr int ND = DQK / 16, NKP = DQK / 8, KPT = (64 * NKP) / 512;
    constexpr size_t SHM_K = 64 * DQK * 2;
    const int tid = otid(), wid = tid >> 6, lane = tid & 63, r32 = lane & 31, hi = lane >> 5;
    char* V_lds = lds; char* K_lds = lds + 2 * A_SHM_V;
    float* wsf = (float*)(lds + 2 * A_SHM_V + 2 * SHM_K) + wid * 64; float* li_l = wsf; float* al_l = wsf + 32;
    float m_reg = -1e30f, l_reg = 0; f32x16 o[4] = {}; bf16x8 qr[ND];
    const bf16_t* Qw = Qb + (long)(wid * 32 + r32) * ldq + hi * 8;
#pragma unroll
    for (int d0 = 0; d0 < ND; ++d0) qr[d0] = *reinterpret_cast<const bf16x8*>(Qw + d0 * 16);
    if constexpr (ROPEQ) {
        if (do_rope) {
            const int s = s0 + wid * 32 + r32; const float rp = (float)(s >> 6), cp = (float)(s & 63);
#pragma unroll
            for (int blk = 0; blk < 2; ++blk) {
                bf16x8 a = qr[8 + blk], bq = qr[10 + blk], oa, ob;
#pragma unroll
                for (int e = 0; e < 8; ++e) {
                    const int j = hi * 8 + e;
                    const float inv = powf(10000.f, -(float)j / 16.f);
                    float sn, cs; sincosf((blk == 0 ? rp : cp) * inv, &sn, &cs);
                    const float x1 = bf2f((bf16_t)a[e]), x2 = bf2f((bf16_t)bq[e]);
                    oa[e] = (short)f2bf(x1 * cs - x2 * sn); ob[e] = (short)f2bf(x2 * cs + x1 * sn);
                }
                qr[8 + blk] = oa; qr[10 + blk] = ob;
            }
        }
    }
    const int sr = tid >> 4, sc = (tid & 15) * 8, vst0 = v_st(sr, sc), vst1 = v_st(32 + sr, sc);
    const int vb0 = (int)(uintptr_t)V_lds + v_rd_base(lane);
    const unsigned voff = sr * ldv + sc;
    unsigned koff[KPT]; int kst[KPT];
#pragma unroll
    for (int i = 0; i < KPT; ++i) { const int p = tid + 512 * i, kr_ = p / NKP, kc_ = (p % NKP) * 8; koff[i] = kr_ * ldk + kc_; kst[i] = kswz<DQK>(kr_, kc_ * 2); }
    struct { bf16x8 vs0, vs1, ks[KPT]; } sr_[2];
#define SLOAD(i, k0) do { const bf16_t* vb_ = Vh + (long)(k0) * ldv; const bf16_t* kb_ = Kh + (long)(k0) * ldk; \
    sr_[i].vs0 = *reinterpret_cast<const bf16x8*>(vb_ + voff); sr_[i].vs1 = *reinterpret_cast<const bf16x8*>(vb_ + 32 * ldv + voff); \
    _Pragma("unroll") for (int i_ = 0; i_ < KPT; ++i_) sr_[i].ks[i_] = *reinterpret_cast<const bf16x8*>(kb_ + koff[i_]); } while (0)
#define SWRITE(b, i) do { *(bf16x8*)(V_lds + (b) * A_SHM_V + vst0) = sr_[i].vs0; *(bf16x8*)(V_lds + (b) * A_SHM_V + vst1) = sr_[i].vs1; \
    _Pragma("unroll") for (int i_ = 0; i_ < KPT; ++i_) *(bf16x8*)(K_lds + (b) * SHM_K + kst[i_]) = sr_[i].ks[i_]; } while (0)
#define SWAIT() asm volatile("s_waitcnt vmcnt(%0)" :: "n"(2 + KPT) : "memory")
#define RESC(a) do { if (__any((a) < 1.f)) { if (hi == 0) al_l[r32] = (a); asm volatile("s_waitcnt lgkmcnt(0)" ::: "memory"); \
    _Pragma("unroll") for (int d = 0; d < 4; ++d) _Pragma("unroll") for (int r = 0; r < 16; ++r) o[d][r] *= al_l[crow(r, hi)]; } } while (0)
    f32x16 pA0, pA1, pB0, pB1; float mnA, mnB, alA, alB; bf16x8 pa0, pa1, pa2, pa3; const int NT = seq / A_KVBLK;
    constexpr int SE = 0, SO = 1;
    SLOAD(SE, 0); asm volatile("s_waitcnt vmcnt(0)" ::: "memory"); SWRITE(0, SE); __syncthreads();
    qkt<DQK>(pA0, pA1, K_lds, qr, r32, hi); partialSM<DQK>(pA0, pA1, m_reg, mnA, alA);
    SLOAD(SO, A_KVBLK); if (2 < NT) SLOAD(SE, 2 * A_KVBLK);
    SWAIT(); SWRITE(1, SO); __syncthreads();
    for (int j = 1; j + 1 < NT; j += 2) {
        SBAR(); qkt<DQK>(pB0, pB1, K_lds + SHM_K, qr, r32, hi);
        finishSM(pA0, pA1, alA, l_reg, pa0, pa1, pa2, pa3); SBAR();
        SLOAD(SO, (j + 2) * A_KVBLK); SBAR();
        pv_d0(o, vb0, pa0, pa1, pa2, pa3); partialSM<DQK>(pB0, pB1, m_reg, mnB, alB);
        __syncthreads(); SWAIT(); SWRITE(0, SE);
        RESC(alB); __syncthreads();
        SBAR(); qkt<DQK>(pA0, pA1, K_lds, qr, r32, hi);
        finishSM(pB0, pB1, alB, l_reg, pa0, pa1, pa2, pa3); SBAR();
        if (j + 3 < NT) SLOAD(SE, (j + 3) * A_KVBLK); SBAR();
        pv_d0(o, vb0 + (int)A_SHM_V, pa0, pa1, pa2, pa3); partialSM<DQK>(pA0, pA1, m_reg, mnA, alA);
        __syncthreads(); SWAIT(); SWRITE(1, SO);
        RESC(alA); __syncthreads();
    }
    SBAR(); qkt<DQK>(pB0, pB1, K_lds + SHM_K, qr, r32, hi);
    finishSM(pA0, pA1, alA, l_reg, pa0, pa1, pa2, pa3); SBAR();
    pv_d0(o, vb0, pa0, pa1, pa2, pa3); partialSM<DQK>(pB0, pB1, m_reg, mnB, alB);
    __syncthreads(); RESC(alB);
    finishSM(pB0, pB1, alB, l_reg, pa0, pa1, pa2, pa3); SBAR();
    pv_d0(o, vb0 + (int)A_SHM_V, pa0, pa1, pa2, pa3);
    if (hi == 0) li_l[r32] = l_reg; asm volatile("s_waitcnt lgkmcnt(0)" ::: "memory");
    float rli[16];
#pragma unroll
    for (int r = 0; r < 16; ++r) rli[r] = __builtin_amdgcn_rcpf(li_l[crow(r, hi)]);
    bf16_t* Ow = Ob + (long)(wid * 32) * ldo;
#pragma unroll
    for (int r = 0; r < 16; ++r) { const int orow = crow(r, hi);
#pragma unroll
        for (int d0 = 0; d0 < 4; ++d0) Ow[(long)orow * ldo + d0 * 32 + r32] = f2bf(o[d0][r] * rli[r]); }
    __syncthreads();
#undef SLOAD
#undef SWRITE
#undef SWAIT
#undef RESC
}

template <int DQK, bool ROPEQ, int ldq, int ldk, int ldv, int ldo>
__device__ __forceinline__ void attn_unit_s(const bf16_t* __restrict__ Qb, const bf16_t* __restrict__ Kh, const bf16_t* __restrict__ Vh,
                                            bf16_t* __restrict__ Ob, int seq, int s0, bool do_rope, char* lds) {
    constexpr int ND = DQK / 16, NKP = DQK / 8, KPT = (64 * NKP) / 512;
    constexpr size_t SHM_K = 64 * DQK * 2;
    const int tid = otid(), wid = tid >> 6, lane = tid & 63, r32 = lane & 31, hi = lane >> 5;
    char* V_lds = lds; char* K_lds = lds + 2 * A_SHM_V;
    float* wsf = (float*)(lds + 2 * A_SHM_V + 2 * SHM_K) + wid * 64; float* li_l = wsf; float* al_l = wsf + 32;
    float m_reg = -1e30f, l_reg = 0; f32x16 o[4] = {}; bf16x8 qr[ND];
    const bf16_t* Qw = Qb + (long)(wid * 32 + r32) * ldq + hi * 8;
#pragma unroll
    for (int d0 = 0; d0 < ND; ++d0) qr[d0] = *reinterpret_cast<const bf16x8*>(Qw + d0 * 16);
    if constexpr (ROPEQ) {
        if (do_rope) {
            const int s = s0 + wid * 32 + r32; const float rp = (float)(s >> 6), cp = (float)(s & 63);
#pragma unroll
            for (int blk = 0; blk < 2; ++blk) {
                bf16x8 a = qr[8 + blk], bq = qr[10 + blk], oa, ob;
#pragma unroll
                for (int e = 0; e < 8; ++e) {
                    const int j = hi * 8 + e;
                    const float inv = powf(10000.f, -(float)j / 16.f);
                    float sn, cs; sincosf((blk == 0 ? rp : cp) * inv, &sn, &cs);
                    const float x1 = bf2f((bf16_t)a[e]), x2 = bf2f((bf16_t)bq[e]);
                    oa[e] = (short)f2bf(x1 * cs - x2 * sn); ob[e] = (short)f2bf(x2 * cs + x1 * sn);
                }
                qr[8 + blk] = oa; qr[10 + blk] = ob;
            }
        }
    }
    const int sr = tid >> 4, sc = (tid & 15) * 8, vst0 = v_st(sr, sc), vst1 = v_st(32 + sr, sc);
    const int vb0 = (int)(uintptr_t)V_lds + v_rd_base(lane);
    const unsigned voff = sr * ldv + sc;
    unsigned koff[KPT]; int kst[KPT];
#pragma unroll
    for (int i = 0; i < KPT; ++i) { const int p = tid + 512 * i, kr_ = p / NKP, kc_ = (p % NKP) * 8; koff[i] = kr_ * ldk + kc_; kst[i] = kswz<DQK>(kr_, kc_ * 2); }
    bf16x8 vs0, vs1, ks[KPT];
#define SLOAD(k0) do { const bf16_t* vb_ = Vh + (long)(k0) * ldv; const bf16_t* kb_ = Kh + (long)(k0) * ldk; \
    vs0 = *reinterpret_cast<const bf16x8*>(vb_ + voff); vs1 = *reinterpret_cast<const bf16x8*>(vb_ + 32 * ldv + voff); \
    _Pragma("unroll") for (int i_ = 0; i_ < KPT; ++i_) ks[i_] = *reinterpret_cast<const bf16x8*>(kb_ + koff[i_]); } while (0)
#define SWRITE(b) do { *(bf16x8*)(V_lds + (b) * A_SHM_V + vst0) = vs0; *(bf16x8*)(V_lds + (b) * A_SHM_V + vst1) = vs1; \
    _Pragma("unroll") for (int i_ = 0; i_ < KPT; ++i_) *(bf16x8*)(K_lds + (b) * SHM_K + kst[i_]) = ks[i_]; } while (0)
    const int NT = seq / A_KVBLK;
    SLOAD(0); asm volatile("s_waitcnt vmcnt(0)" ::: "memory"); SWRITE(0); __syncthreads();
    SLOAD(A_KVBLK);
#pragma unroll 1
    for (int j = 0; j < NT; ++j) {
        const int buf = j & 1;
        f32x16 p0, p1; float mn, alpha; bf16x8 pa0, pa1, pa2, pa3;
        qkt<DQK>(p0, p1, K_lds + buf * SHM_K, qr, r32, hi);
        partialSM<DQK>(p0, p1, m_reg, mn, alpha);
        finishSM(p0, p1, alpha, l_reg, pa0, pa1, pa2, pa3);
        if (__any(alpha < 1.f)) { if (hi == 0) al_l[r32] = alpha; asm volatile("s_waitcnt lgkmcnt(0)" ::: "memory");
#pragma unroll
            for (int d = 0; d < 4; ++d)
#pragma unroll
                for (int r = 0; r < 16; ++r) o[d][r] *= al_l[crow(r, hi)]; }
        if (j + 1 < NT) SWRITE(buf ^ 1);
        SBAR();
        pv_d0(o, vb0 + buf * (int)A_SHM_V, pa0, pa1, pa2, pa3);
        __syncthreads();
        if (j + 2 < NT) SLOAD((j + 2) * A_KVBLK);
    }
    if (hi == 0) li_l[r32] = l_reg; asm volatile("s_waitcnt lgkmcnt(0)" ::: "memory");
    float rli[16];
#pragma unroll
    for (int r = 0; r < 16; ++r) rli[r] = __builtin_amdgcn_rcpf(li_l[crow(r, hi)]);
    bf16_t* Ow = Ob + (long)(wid * 32) * ldo;
#pragma unroll
    for (int r = 0; r < 16; ++r) { const int orow = crow(r, hi);
#pragma unroll
        for (int d0 = 0; d0 < 4; ++d0) Ow[(long)orow * ldo + d0 * 32 + r32] = f2bf(o[d0][r] * rli[r]); }
    __syncthreads();
#undef SLOAD
#undef SWRITE
}

template <int DQK, bool ROPEQ, int ldq, int ldk, int ldv, int ldo>
__device__ __forceinline__ void attn_unit_pp(const bf16_t* __restrict__ Qb, const bf16_t* __restrict__ Kh, const bf16_t* __restrict__ Vh,
                                             bf16_t* __restrict__ Ob, int seq, int s0, bool do_rope, char* lds) {
    constexpr int ND = DQK / 16, NKP = DQK / 8, KPT = (64 * NKP) / 512;
    constexpr size_t SHM_K = 64 * DQK * 2;
    const int tid = otid(), wid = tid >> 6, lane = tid & 63, r32 = lane & 31, hi = lane >> 5, half = wid >> 2;
    char* V_lds = lds; char* K_lds = lds + 2 * A_SHM_V;
    float* wsf = (float*)(lds + 2 * A_SHM_V + 2 * SHM_K) + wid * 64; float* li_l = wsf; float* al_l = wsf + 32;
    float m_reg = -1e30f, l_reg = 0; f32x16 o[4] = {}; bf16x8 qr[ND];
    const bf16_t* Qw = Qb + (long)(wid * 32 + r32) * ldq + hi * 8;
#pragma unroll
    for (int d0 = 0; d0 < ND; ++d0) qr[d0] = *reinterpret_cast<const bf16x8*>(Qw + d0 * 16);
    if constexpr (ROPEQ) {
        if (do_rope) {
            const int s = s0 + wid * 32 + r32; const float rp = (float)(s >> 6), cp = (float)(s & 63);
#pragma unroll
            for (int blk = 0; blk < 2; ++blk) {
                bf16x8 a = qr[8 + blk], bq = qr[10 + blk], oa, ob;
#pragma unroll
                for (int e = 0; e < 8; ++e) {
                    const int j = hi * 8 + e;
                    const float inv = powf(10000.f, -(float)j / 16.f);
                    float sn, cs; sincosf((blk == 0 ? rp : cp) * inv, &sn, &cs);
                    const float x1 = bf2f((bf16_t)a[e]), x2 = bf2f((bf16_t)bq[e]);
                    oa[e] = (short)f2bf(x1 * cs - x2 * sn); ob[e] = (short)f2bf(x2 * cs + x1 * sn);
                }
                qr[8 + blk] = oa; qr[10 + blk] = ob;
            }
        }
    }
    const int sr = tid >> 4, sc = (tid & 15) * 8, vst0 = v_st(sr, sc), vst1 = v_st(32 + sr, sc);
    const int vb0 = (int)(uintptr_t)V_lds + v_rd_base(lane);
    const unsigned voff = sr * ldv + sc;
    unsigned koff[KPT]; int kst[KPT];
#pragma unroll
    for (int i = 0; i < KPT; ++i) { const int p = tid + 512 * i, kr_ = p / NKP, kc_ = (p % NKP) * 8; koff[i] = kr_ * ldk + kc_; kst[i] = kswz<DQK>(kr_, kc_ * 2); }
    bf16x8 vs0, vs1, ks[KPT];
#define LOADK(k0) do { const bf16_t* kb_ = Kh + (long)(k0) * ldk; _Pragma("unroll") for (int i_ = 0; i_ < KPT; ++i_) ks[i_] = *reinterpret_cast<const bf16x8*>(kb_ + koff[i_]); } while (0)
#define LOADV(k0) do { const bf16_t* vb_ = Vh + (long)(k0) * ldv; vs0 = *reinterpret_cast<const bf16x8*>(vb_ + voff); vs1 = *reinterpret_cast<const bf16x8*>(vb_ + 32 * ldv + voff); } while (0)
#define WRITEK(b) do { _Pragma("unroll") for (int i_ = 0; i_ < KPT; ++i_) *(bf16x8*)(K_lds + (b) * SHM_K + kst[i_]) = ks[i_]; } while (0)
#define WRITEV(b) do { *(bf16x8*)(V_lds + (b) * A_SHM_V + vst0) = vs0; *(bf16x8*)(V_lds + (b) * A_SHM_V + vst1) = vs1; } while (0)
#define RAWBAR() do { asm volatile("s_waitcnt lgkmcnt(0)" ::: "memory"); __builtin_amdgcn_s_barrier(); asm volatile("" ::: "memory"); } while (0)
    const int NT = seq / A_KVBLK;
    LOADK(0); asm volatile("s_waitcnt vmcnt(0)" ::: "memory"); WRITEK(0);
    LOADK(A_KVBLK); LOADV(0);
    __syncthreads();
    if (half == 1) RAWBAR();
    f32x16 p0, p1; float mn, alpha; bf16x8 pa0, pa1, pa2, pa3;
#pragma unroll 1
    for (int x = 0; x < NT; ++x) {
        __builtin_amdgcn_s_setprio(1);
        qkt<DQK>(p0, p1, K_lds + (x & 1) * SHM_K, qr, r32, hi);
        if (x > 0) pv_d0(o, vb0 + ((x - 1) & 1) * (int)A_SHM_V, pa0, pa1, pa2, pa3);
        __builtin_amdgcn_s_setprio(0);
        if (x + 1 < NT) WRITEK((x + 1) & 1);
        WRITEV(x & 1);
        if (x + 2 < NT) LOADK((x + 2) * A_KVBLK);
        if (x + 1 < NT) LOADV((x + 1) * A_KVBLK);
        RAWBAR();
        partialSM<DQK>(p0, p1, m_reg, mn, alpha);
        finishSM(p0, p1, alpha, l_reg, pa0, pa1, pa2, pa3);
        if (__any(alpha < 1.f)) { if (hi == 0) al_l[r32] = alpha; asm volatile("s_waitcnt lgkmcnt(0)" ::: "memory");
#pragma unroll
            for (int d = 0; d < 4; ++d)
#pragma unroll
                for (int r = 0; r < 16; ++r) o[d][r] *= al_l[crow(r, hi)]; }
        RAWBAR();
    }
    pv_d0(o, vb0 + ((NT - 1) & 1) * (int)A_SHM_V, pa0, pa1, pa2, pa3);
    if (half == 0) RAWBAR();
    if (hi == 0) li_l[r32] = l_reg; asm volatile("s_waitcnt lgkmcnt(0)" ::: "memory");
    float rli[16];
#pragma unroll
    for (int r = 0; r < 16; ++r) rli[r] = __builtin_amdgcn_rcpf(li_l[crow(r, hi)]);
    bf16_t* Ow = Ob + (long)(wid * 32) * ldo;
#pragma unroll
    for (int r = 0; r < 16; ++r) { const int orow = crow(r, hi);
#pragma unroll
        for (int d0 = 0; d0 < 4; ++d0) Ow[(long)orow * ldo + d0 * 32 + r32] = f2bf(o[d0][r] * rli[r]); }
    __syncthreads();
#undef LOADK
#undef LOADV
#undef WRITEK
#undef WRITEV
#undef RAWBAR
}

template <int DQK> __device__ __forceinline__ int k8_addr(int row, int chunk) {
    if constexpr (DQK == 192) return row * 256 + ((chunk ^ (row & 15)) << 4);
    else return row * 128 + ((chunk ^ ((row >> 1) & 7)) << 4);
}
__device__ __forceinline__ int vt_addr(int col, int chunk) { return col * 64 + ((chunk ^ ((col >> 2) & 3)) << 4); }
template <int DQK, bool ROPEQ, int ldq, int ldk8, int ldo>
__device__ __forceinline__ void attn_unit_f8(const bf16_t* __restrict__ Qb, const unsigned char* __restrict__ K8, const unsigned char* __restrict__ VT,
                                             unsigned char* __restrict__ Ob, int seq, int s0, bool do_rope, char* lds) {
    constexpr int NS = DQK / 64, NKP = DQK / 16, KROW = DQK == 192 ? 256 : 128;
    constexpr int SHM_K8 = 128 * KROW, SHM_VT = 16384;
    constexpr int KPT = (128 * NKP) / 512;
    constexpr float SCALE = (DQK == 128) ? 0.088388347648318440f : 0.072168783648703220f;
    constexpr float C = SCALE * 1.4426950408889634f, THR = 1.5f;
    const int tid = otid(), wid = tid >> 6, lane = tid & 63, r32 = lane & 31, hi = lane >> 5;
    char* K_lds = lds; char* V_lds = lds + 2 * SHM_K8;
    float* al_l = (float*)(lds + 2 * SHM_K8 + 2 * SHM_VT) + wid * 32;
    float m_reg = -1e30f, l_reg = 0.f; f32x16 o[4];
    { float z0 = 0.f; asm volatile("" : "+v"(z0));
#pragma unroll
      for (int d = 0; d < 4; ++d)
#pragma unroll
          for (int r = 0; r < 16; ++r) o[d][r] = z0; }
    constexpr int KD = SHM_K8 / 8192, CH = KROW / 16;
    unsigned kgo[KD];
#pragma unroll
    for (int i_ = 0; i_ < KD; ++i_) { const int slot = tid + 512 * i_, row = slot / CH, pos = slot % CH; int chunk = pos ^ (DQK == 192 ? (row & 15) : ((row >> 1) & 7)); if (chunk >= NKP) chunk = 0; kgo[i_] = row * ldk8 + chunk * 16; }
    const unsigned vgo = (tid >> 2) * 64 + (((tid & 3) ^ ((tid >> 4) & 3)) << 4);
#define DMA8(b, k0) do { const unsigned char* kb_ = K8 + (long)(k0) * ldk8; const unsigned char* vb_ = VT + (long)((k0) >> 6) * 8192 + vgo; \
    _Pragma("unroll") for (int i_ = 0; i_ < KD; ++i_) __builtin_amdgcn_global_load_lds((const unsigned*)(kb_ + kgo[i_]), (unsigned*)(K_lds + (b) * SHM_K8 + i_ * 8192 + tid * 16), 16, 0, 0); \
    __builtin_amdgcn_global_load_lds((const unsigned*)(vb_), (unsigned*)(V_lds + (b) * SHM_VT + tid * 16), 16, 0, 0); \
    __builtin_amdgcn_global_load_lds((const unsigned*)(vb_ + 8192), (unsigned*)(V_lds + (b) * SHM_VT + 8192 + tid * 16), 16, 0, 0); } while (0)
    DMA8(0, 0);
    i32x8 qf[NS];
    {
        const bf16_t* Qw = Qb + (long)(wid * 32 + r32) * ldq + hi * 32;
#pragma unroll
        for (int sidx = 0; sidx < NS; ++sidx) {
            float qv[32];
#pragma unroll
            for (int c8 = 0; c8 < 4; ++c8) { const bf16x8 t = *reinterpret_cast<const bf16x8*>(Qw + sidx * 64 + c8 * 8);
#pragma unroll
                for (int e = 0; e < 8; ++e) qv[c8 * 8 + e] = bf2f((bf16_t)t[e]); }
            if constexpr (ROPEQ) {
                if (sidx == 2 && do_rope) {
                    const int sq = s0 + wid * 32 + r32; const float rp = (float)(sq >> 6), cp = (float)(sq & 63);
#pragma unroll
                    for (int e = 0; e < 32; ++e) {
                        constexpr float IFR[16] = {1.591549431e-01f, 8.949976069e-02f, 5.032921210e-02f, 2.830207916e-02f, 1.591549431e-02f, 8.949976069e-03f, 5.032921210e-03f, 2.830207916e-03f, 1.591549431e-03f, 8.949976069e-04f, 5.032921210e-04f, 2.830207916e-04f, 1.591549431e-04f, 8.949976069e-05f, 5.032921210e-05f, 2.830207916e-05f};
                        const float rev = (e < 16 ? rp : cp) * IFR[e & 15];
                        const float sn = __builtin_amdgcn_sinf(rev), cs = __builtin_amdgcn_cosf(rev);
                        const float other = half_other(qv[e], hi == 0);
                        qv[e] = hi == 0 ? qv[e] * cs - other * sn : qv[e] * cs + other * sn;
                    }
                }
            }
#pragma unroll
            for (int v = 0; v < 8; ++v) qf[sidx][v] = (int)f2f8x4(qv[4 * v], qv[4 * v + 1], qv[4 * v + 2], qv[4 * v + 3]);
        }
    }
    const char* kp[NS][2]; const char* vp[2];
#pragma unroll
    for (int sidx = 0; sidx < NS; ++sidx)
#pragma unroll
        for (int e = 0; e < 2; ++e) kp[sidx][e] = K_lds + k8_addr<DQK>(r32, 4 * sidx + 2 * hi + e);
#pragma unroll
    for (int e = 0; e < 2; ++e) vp[e] = V_lds + vt_addr(r32, 2 * hi + e);
    const int NT = seq / 128;
    asm volatile("s_waitcnt vmcnt(0)" ::: "memory"); __syncthreads();
#define F8_SUB(BUF, T2) do { \
        f32x16 p0 = {}, p1 = {}; \
        _Pragma("unroll") for (int sidx = 0; sidx < NS; ++sidx) { \
            const i32x4 a0 = *reinterpret_cast<const i32x4*>(kp[sidx][0] + (BUF) * SHM_K8 + (2 * (T2)) * 32 * KROW), a1 = *reinterpret_cast<const i32x4*>(kp[sidx][1] + (BUF) * SHM_K8 + (2 * (T2)) * 32 * KROW); \
            const i32x4 b0 = *reinterpret_cast<const i32x4*>(kp[sidx][0] + (BUF) * SHM_K8 + (2 * (T2) + 1) * 32 * KROW), b1 = *reinterpret_cast<const i32x4*>(kp[sidx][1] + (BUF) * SHM_K8 + (2 * (T2) + 1) * 32 * KROW); \
            p0 = __builtin_amdgcn_mfma_scale_f32_32x32x64_f8f6f4(__builtin_shufflevector(a0, a1, 0, 1, 2, 3, 4, 5, 6, 7), qf[sidx], p0, 0, 0, 0, 0x7f7f7f7f, 0, 0x7f7f7f7f); \
            p1 = __builtin_amdgcn_mfma_scale_f32_32x32x64_f8f6f4(__builtin_shufflevector(b0, b1, 0, 1, 2, 3, 4, 5, 6, 7), qf[sidx], p1, 0, 0, 0, 0x7f7f7f7f, 0, 0x7f7f7f7f); } \
        float pm0 = __builtin_amdgcn_fmed3f(p0[0], p0[1], __builtin_inff()), pm1 = __builtin_amdgcn_fmed3f(p1[0], p1[1], __builtin_inff());     \
        _Pragma("unroll") for (int r = 2; r < 16; ++r) { pm0 = __builtin_amdgcn_fmed3f(pm0, p0[r], __builtin_inff()); pm1 = __builtin_amdgcn_fmed3f(pm1, p1[r], __builtin_inff()); } \
        float pmax = __builtin_amdgcn_fmed3f(pm0, pm1, __builtin_inff()); \
        { auto rr = __builtin_amdgcn_permlane32_swap(__float_as_uint(pmax), __float_as_uint(pmax), false, false); pmax = fmaxf(__uint_as_float(rr[0]), __uint_as_float(rr[1])); } \
        float alpha = 1.f; \
        if (!__builtin_expect(__all(pmax - m_reg <= THR / SCALE), 1)) { const float mn = fmaxf(m_reg, pmax); alpha = __builtin_amdgcn_exp2f((m_reg - mn) * C); m_reg = mn; } \
        const float mnC = 6.f - m_reg * C; \
        float ps = 0.f; \
        _Pragma("unroll") for (int r = 0; r < 16; ++r) { p0[r] = __builtin_amdgcn_exp2f(fmaf(p0[r], C, mnC)); p1[r] = __builtin_amdgcn_exp2f(fmaf(p1[r], C, mnC)); ps += p0[r] + p1[r]; } \
        l_reg = l_reg * alpha + half_sum(ps); \
        i32x8 pf; \
        _Pragma("unroll") for (int v = 0; v < 4; ++v) { pf[v] = (int)f2f8x4(p0[4 * v], p0[4 * v + 1], p0[4 * v + 2], p0[4 * v + 3]); pf[4 + v] = (int)f2f8x4(p1[4 * v], p1[4 * v + 1], p1[4 * v + 2], p1[4 * v + 3]); } \
        if (__any(alpha < 1.f)) { if (hi == 0) al_l[r32] = alpha; asm volatile("s_waitcnt lgkmcnt(0)" ::: "memory"); \
            _Pragma("unroll") for (int d = 0; d < 4; ++d) _Pragma("unroll") for (int r = 0; r < 16; ++r) o[d][r] *= al_l[crow(r, hi)]; } \
        _Pragma("unroll") for (int d0 = 0; d0 < 4; ++d0) { \
            const i32x4 v0 = *reinterpret_cast<const i32x4*>(vp[0] + (BUF) * SHM_VT + (T2) * 8192 + d0 * 2048), v1 = *reinterpret_cast<const i32x4*>(vp[1] + (BUF) * SHM_VT + (T2) * 8192 + d0 * 2048); \
            o[d0] = __builtin_amdgcn_mfma_scale_f32_32x32x64_f8f6f4(pf, __builtin_shufflevector(v0, v1, 0, 1, 2, 3, 4, 5, 6, 7), o[d0], 0, 0, 0, 0x7f7f7f7f, 0, 0x7f7f7f7f); } \
    } while (0)
#define F8_TILE(BUF, J) do { \
        if ((J) + 1 < NT) DMA8((BUF) ^ 1, ((J) + 1) * 128);        \
        F8_SUB(BUF, 0); __builtin_amdgcn_sched_barrier(0); F8_SUB(BUF, 1); \
        asm volatile("s_waitcnt vmcnt(0)" ::: "memory"); __syncthreads(); \
    } while (0)
    if (wid >= 4) __builtin_amdgcn_s_setprio(1);
#pragma unroll 1
    for (int j = 0; j < NT; j += 2) { F8_TILE(0, j); F8_TILE(1, j + 1); }
    __builtin_amdgcn_s_setprio(0);
    unsigned char* Ow = Ob + (long)(wid * 32) * ldo;
    if (hi == 0) al_l[r32] = l_reg; asm volatile("s_waitcnt lgkmcnt(0)" ::: "memory");
#pragma unroll
    for (int r = 0; r < 16; ++r) { const int orow = crow(r, hi); const float rl = 32.f * __builtin_amdgcn_rcpf(al_l[orow]);
#pragma unroll
        for (int d0 = 0; d0 < 4; ++d0) Ow[(long)orow * ldo + d0 * 32 + r32] = f2f8(o[d0][r] * rl); }
    __syncthreads();
#undef DMA8
#undef F8_TILE
#undef F8_SUB
}

template <int DQK, bool ROPEQ, int ldq, int ldk8, int ldo, int KSTEP>
__device__ __forceinline__ void attn_unit_f8h(const bf16_t* __restrict__ Qb, const unsigned char* __restrict__ K8, const unsigned char* __restrict__ VT,
                                             unsigned char* __restrict__ Ob, int seq, int s0, bool do_rope, char* lds) {
    constexpr int NS = DQK / 64, NKP = DQK / 16, KROW = DQK == 192 ? 256 : 128;
    constexpr int NSUB = KSTEP / 64, SHM_K8 = KSTEP * KROW, SHM_VT = NSUB * 8192, HB = 2 * (SHM_K8 + SHM_VT);
    constexpr float SCALE = (DQK == 128) ? 0.088388347648318440f : 0.072168783648703220f;
    constexpr float C = SCALE * 1.4426950408889634f, THR = 1.5f;
    const int tid = otid(), wid = tid >> 6, lane = tid & 63, r32 = lane & 31, hi = lane >> 5, half = wid >> 2, tl = tid & 255;
    char* K_lds = lds + half * HB; char* V_lds = K_lds + 2 * SHM_K8;
    float* al_l = (float*)(lds + 2 * HB) + wid * 32;
    volatile LAS unsigned* hcnt = (volatile LAS unsigned*)(lds + 2 * HB + 1024) + half * 16;
    unsigned htarget = 0u;
    float m_reg = -1e30f, l_reg = 0.f; f32x16 o[4];
    { float z0 = 0.f; asm volatile("" : "+v"(z0));
#pragma unroll
      for (int d = 0; d < 4; ++d)
#pragma unroll
          for (int r = 0; r < 16; ++r) o[d][r] = z0; }
    i32x8 qf[NS];
    {
        const bf16_t* Qw = Qb + (long)(wid * 32 + r32) * ldq + hi * 32;
#pragma unroll
        for (int sidx = 0; sidx < NS; ++sidx) {
            float qv[32];
#pragma unroll
            for (int c8 = 0; c8 < 4; ++c8) { const bf16x8 t = *reinterpret_cast<const bf16x8*>(Qw + sidx * 64 + c8 * 8);
#pragma unroll
                for (int e = 0; e < 8; ++e) qv[c8 * 8 + e] = bf2f((bf16_t)t[e]); }
            if constexpr (ROPEQ) {
                if (sidx == 2 && do_rope) {
                    const int sq = s0 + wid * 32 + r32; const float rp = (float)(sq >> 6), cp = (float)(sq & 63);
#pragma unroll
                    for (int e = 0; e < 32; ++e) {
                        constexpr float IFR[16] = {1.591549431e-01f, 8.949976069e-02f, 5.032921210e-02f, 2.830207916e-02f, 1.591549431e-02f, 8.949976069e-03f, 5.032921210e-03f, 2.830207916e-03f, 1.591549431e-03f, 8.949976069e-04f, 5.032921210e-04f, 2.830207916e-04f, 1.591549431e-04f, 8.949976069e-05f, 5.032921210e-05f, 2.830207916e-05f};
                        const float rev = (e < 16 ? rp : cp) * IFR[e & 15];
                        const float sn = __builtin_amdgcn_sinf(rev), cs = __builtin_amdgcn_cosf(rev);
                        const float other = half_other(qv[e], hi == 0);
                        qv[e] = hi == 0 ? qv[e] * cs - other * sn : qv[e] * cs + other * sn;
                    }
                }
            }
#pragma unroll
            for (int v = 0; v < 8; ++v) qf[sidx][v] = (int)f2f8x4(qv[4 * v], qv[4 * v + 1], qv[4 * v + 2], qv[4 * v + 3]);
        }
    }
    constexpr int KD = SHM_K8 / 4096, VD = SHM_VT / 4096, CH = KROW / 16;
    unsigned kgo[KD], vgo[VD];
#pragma unroll
    for (int i_ = 0; i_ < KD; ++i_) { const int slot = tl + 256 * i_, row = slot / CH, pos = slot % CH; int chunk = pos ^ (DQK == 192 ? (row & 15) : ((row >> 1) & 7)); if (chunk >= NKP) chunk = 0; kgo[i_] = row * ldk8 + chunk * 16; }
#pragma unroll
    for (int i_ = 0; i_ < VD; ++i_) { const int slot = tl + 256 * i_, t2 = slot >> 9, wi = slot & 511, col = wi >> 2; vgo[i_] = t2 * 8192 + col * 64 + (((wi & 3) ^ ((col >> 2) & 3)) << 4); }
#define DMA8(b, k0) do { const unsigned char* kb_ = K8 + (long)(k0) * ldk8; const unsigned char* vb_ = VT + (long)((k0) >> 6) * 8192; \
    _Pragma("unroll") for (int i_ = 0; i_ < KD; ++i_) __builtin_amdgcn_global_load_lds((const unsigned*)(kb_ + kgo[i_]), (unsigned*)(K_lds + (b) * SHM_K8 + i_ * 4096 + tl * 16), 16, 0, 0); \
    _Pragma("unroll") for (int i_ = 0; i_ < VD; ++i_) __builtin_amdgcn_global_load_lds((const unsigned*)(vb_ + vgo[i_]), (unsigned*)(V_lds + (b) * SHM_VT + i_ * 4096 + tl * 16), 16, 0, 0); } while (0)
#define HBAR() do { asm volatile("s_waitcnt vmcnt(0) lgkmcnt(0)" ::: "memory"); \
    if (lane == 0) __hip_atomic_fetch_add((LAS unsigned*)hcnt, 1u, __ATOMIC_RELAXED, __HIP_MEMORY_SCOPE_WORKGROUP); \
    htarget += 4u; \
    while ((unsigned)__builtin_amdgcn_readfirstlane((int)__hip_atomic_load((LAS unsigned*)hcnt, __ATOMIC_RELAXED, __HIP_MEMORY_SCOPE_WORKGROUP)) < htarget) __builtin_amdgcn_s_sleep(1); \
    __builtin_amdgcn_s_sleep(4); asm volatile("s_waitcnt vmcnt(0) lgkmcnt(0)" ::: "memory"); } while (0)
    const char* kp[NS][2]; const char* vp[2];
#pragma unroll
    for (int sidx = 0; sidx < NS; ++sidx)
#pragma unroll
        for (int e = 0; e < 2; ++e) kp[sidx][e] = K_lds + k8_addr<DQK>(r32, 4 * sidx + 2 * hi + e);
#pragma unroll
    for (int e = 0; e < 2; ++e) vp[e] = V_lds + vt_addr(r32, 2 * hi + e);
    const int NT = seq / KSTEP;
    if (tl == 0) *hcnt = 0u;
    __syncthreads();
    DMA8(0, 0); HBAR();
#define F8_SUB(BUF, T2) do { \
        f32x16 p0 = {}, p1 = {}; \
        _Pragma("unroll") for (int sidx = 0; sidx < NS; ++sidx) { \
            const i32x4 a0 = *reinterpret_cast<const i32x4*>(kp[sidx][0] + (BUF) * SHM_K8 + (2 * (T2)) * 32 * KROW), a1 = *reinterpret_cast<const i32x4*>(kp[sidx][1] + (BUF) * SHM_K8 + (2 * (T2)) * 32 * KROW); \
            const i32x4 b0 = *reinterpret_cast<const i32x4*>(kp[sidx][0] + (BUF) * SHM_K8 + (2 * (T2) + 1) * 32 * KROW), b1 = *reinterpret_cast<const i32x4*>(kp[sidx][1] + (BUF) * SHM_K8 + (2 * (T2) + 1) * 32 * KROW); \
            p0 = __builtin_amdgcn_mfma_scale_f32_32x32x64_f8f6f4(__builtin_shufflevector(a0, a1, 0, 1, 2, 3, 4, 5, 6, 7), qf[sidx], p0, 0, 0, 0, 0x7f7f7f7f, 0, 0x7f7f7f7f); \
            p1 = __builtin_amdgcn_mfma_scale_f32_32x32x64_f8f6f4(__builtin_shufflevector(b0, b1, 0, 1, 2, 3, 4, 5, 6, 7), qf[sidx], p1, 0, 0, 0, 0x7f7f7f7f, 0, 0x7f7f7f7f); } \
        float pm0 = __builtin_amdgcn_fmed3f(p0[0], p0[1], __builtin_inff()), pm1 = __builtin_amdgcn_fmed3f(p1[0], p1[1], __builtin_inff());     \
        _Pragma("unroll") for (int r = 2; r < 16; ++r) { pm0 = __builtin_amdgcn_fmed3f(pm0, p0[r], __builtin_inff()); pm1 = __builtin_amdgcn_fmed3f(pm1, p1[r], __builtin_inff()); } \
        float pmax = __builtin_amdgcn_fmed3f(pm0, pm1, __builtin_inff()); \
        { auto rr = __builtin_amdgcn_permlane32_swap(__float_as_uint(pmax), __float_as_uint(pmax), false, false); pmax = fmaxf(__uint_as_float(rr[0]), __uint_as_float(rr[1])); } \
        float alpha = 1.f; \
        if (!__builtin_expect(__all(pmax - m_reg <= THR / SCALE), 1)) { const float mn = fmaxf(m_reg, pmax); alpha = __builtin_amdgcn_exp2f((m_reg - mn) * C); m_reg = mn; } \
        const float mnC = 6.f - m_reg * C; \
        float ps = 0.f; \
        _Pragma("unroll") for (int r = 0; r < 16; ++r) { p0[r] = __builtin_amdgcn_exp2f(fmaf(p0[r], C, mnC)); p1[r] = __builtin_amdgcn_exp2f(fmaf(p1[r], C, mnC)); ps += p0[r] + p1[r]; } \
        l_reg = l_reg * alpha + half_sum(ps); \
        i32x8 pf; \
        _Pragma("unroll") for (int v = 0; v < 4; ++v) { pf[v] = (int)f2f8x4(p0[4 * v], p0[4 * v + 1], p0[4 * v + 2], p0[4 * v + 3]); pf[4 + v] = (int)f2f8x4(p1[4 * v], p1[4 * v + 1], p1[4 * v + 2], p1[4 * v + 3]); } \
        if (__any(alpha < 1.f)) { if (hi == 0) al_l[r32] = alpha; asm volatile("s_waitcnt lgkmcnt(0)" ::: "memory"); \
            _Pragma("unroll") for (int d = 0; d < 4; ++d) _Pragma("unroll") for (int r = 0; r < 16; ++r) o[d][r] *= al_l[crow(r, hi)]; } \
        _Pragma("unroll") for (int d0 = 0; d0 < 4; ++d0) { \
            const i32x4 v0 = *reinterpret_cast<const i32x4*>(vp[0] + (BUF) * SHM_VT + (T2) * 8192 + d0 * 2048), v1 = *reinterpret_cast<const i32x4*>(vp[1] + (BUF) * SHM_VT + (T2) * 8192 + d0 * 2048); \
            o[d0] = __builtin_amdgcn_mfma_scale_f32_32x32x64_f8f6f4(pf, __builtin_shufflevector(v0, v1, 0, 1, 2, 3, 4, 5, 6, 7), o[d0], 0, 0, 0, 0x7f7f7f7f, 0, 0x7f7f7f7f); } \
    } while (0)
#define F8_TILE(BUF, J) do { \
        if ((J) + 1 < NT) DMA8((BUF) ^ 1, ((J) + 1) * KSTEP);        \
        F8_SUB(BUF, 0); if constexpr (NSUB == 2) { __builtin_amdgcn_sched_barrier(0); F8_SUB(BUF, 1); } \
        HBAR(); \
    } while (0)
#pragma unroll 1
    for (int j = 0; j < NT; j += 2) { F8_TILE(0, j); F8_TILE(1, j + 1); }
    unsigned char* Ow = Ob + (long)(wid * 32) * ldo;
    if (hi == 0) al_l[r32] = l_reg; asm volatile("s_waitcnt lgkmcnt(0)" ::: "memory");
#pragma unroll
    for (int r = 0; r < 16; ++r) { const int orow = crow(r, hi); const float rl = 32.f * __builtin_amdgcn_rcpf(al_l[orow]);
#pragma unroll
        for (int d0 = 0; d0 < 4; ++d0) Ow[(long)orow * ldo + d0 * 32 + r32] = f2f8(o[d0][r] * rl); }
    __syncthreads();
#undef DMA8
#undef HBAR
#undef F8_TILE
#undef F8_SUB
}

__device__ __forceinline__ void adaln_unit(CP p, int u, char* lds) {
    const int l = u / 192, cb = u % 192, tid = otid(), kc = tid >> 4, cq = tid & 15;
    const float* W = p->in[4] + (size_t)l * 2048 * 12288 + cb * 64 + cq * 4;
    const float* c = p->in[1]; const float* cc = p->in[3];
    f32x4 a0 = {0, 0, 0, 0}, a1 = a0, a2 = a0;
#pragma unroll 4
    for (int kk = 0; kk < 64; ++kk) {
        const int k = kc * 64 + kk;
        const f32x4 w = *reinterpret_cast<const f32x4*>(W + (size_t)k * 12288);
        const float s0 = silu_f(c[k]), s1 = silu_f(c[2048 + k]), s2 = silu_f(cc[k]);
        a0 += w * s0; a1 += w * s1; a2 += w * s2;
    }
    float* red = (float*)lds;
    float* r = red + (kc * 16 + cq) * 12;
#pragma unroll
    for (int j = 0; j < 4; ++j) { r[j] = a0[j]; r[4 + j] = a1[j]; r[8 + j] = a2[j]; }
    __syncthreads();
    if (tid < 192) {
        const int q = tid / 12, e = tid % 12, row = e >> 2, j = e & 3;
        float s = 0.f;
        for (int k2 = 0; k2 < 32; ++k2) s += red[(k2 * 16 + q) * 12 + e];
        const int col = cb * 64 + q * 4 + j;
        float* MOD = (float*)(p->ws + WS_MOD);
        MOD[((size_t)l * 3 + row) * 12288 + col] = s + p->in[5][(size_t)l * 12288 + col];
    }
    __syncthreads();
}

__device__ __forceinline__ void cvt_tile(const float* __restrict__ src, int ldsrc, int k0, int n0, bf16_t* __restrict__ dst, int drow0, int ldd, const float* __restrict__ kscale, char* lds) {
    float* tile = (float*)lds;
    const int tid = otid();
#pragma unroll
    for (int it = 0; it < 2; ++it) {
        const int kk = (tid >> 4) + 32 * it, nq = (tid & 15) * 4;
        f32x4 v = *reinterpret_cast<const f32x4*>(src + (size_t)(k0 + kk) * ldsrc + n0 + nq);
        if (kscale) v *= kscale[k0 + kk];
        tile[kk * 65 + nq + 0] = v[0]; tile[kk * 65 + nq + 1] = v[1]; tile[kk * 65 + nq + 2] = v[2]; tile[kk * 65 + nq + 3] = v[3];
    }
    __syncthreads();
    { const int n = tid >> 3, kq = (tid & 7) * 8;
      u32x4 w;
#pragma unroll
      for (int i = 0; i < 4; ++i) w[i] = cvtpk(tile[(kq + 2 * i) * 65 + n], tile[(kq + 2 * i + 1) * 65 + n]);
      *reinterpret_cast<u32x4*>(dst + (size_t)(drow0 + n) * ldd + k0 + kq) = w; }
    __syncthreads();
}

__device__ __forceinline__ void cvt_tile_f8(const float* __restrict__ src, int ldsrc, int k0, int n0, unsigned char* __restrict__ dst, int drow0, int ldd, float scale, char* lds) {
    float* tile = (float*)lds;
    const int tid = otid();
#pragma unroll
    for (int it = 0; it < 2; ++it) {
        const int kk = (tid >> 4) + 32 * it, nq = (tid & 15) * 4;
        const f32x4 v = *reinterpret_cast<const f32x4*>(src + (size_t)(k0 + kk) * ldsrc + n0 + nq) * scale;
        tile[kk * 65 + nq + 0] = v[0]; tile[kk * 65 + nq + 1] = v[1]; tile[kk * 65 + nq + 2] = v[2]; tile[kk * 65 + nq + 3] = v[3];
    }
    __syncthreads();
    { const int n = tid >> 3, kq = (tid & 7) * 8;
      u32x2 w = {f2f8x4(tile[(kq + 0) * 65 + n], tile[(kq + 1) * 65 + n], tile[(kq + 2) * 65 + n], tile[(kq + 3) * 65 + n]),
                 f2f8x4(tile[(kq + 4) * 65 + n], tile[(kq + 5) * 65 + n], tile[(kq + 6) * 65 + n], tile[(kq + 7) * 65 + n])};
      *reinterpret_cast<u32x2*>(dst + (size_t)(drow0 + n) * ldd + k0 + kq) = w; }
    __syncthreads();
}

__device__ __forceinline__ void cvt_tile_f8w(const float* __restrict__ src, int ldsrc, int k0, int n0, unsigned char* __restrict__ dst, int drow0, int ldd, float scale, char* lds) {
    float* tile = (float*)lds;
    const int tid = otid();
#pragma unroll
    for (int it = 0; it < 4; ++it) {
        const int kk = (tid >> 4) + 32 * it, nq = (tid & 15) * 4;
        const f32x4 v = *reinterpret_cast<const f32x4*>(src + (size_t)(k0 + kk) * ldsrc + n0 + nq) * scale;
        tile[kk * 65 + nq + 0] = v[0]; tile[kk * 65 + nq + 1] = v[1]; tile[kk * 65 + nq + 2] = v[2]; tile[kk * 65 + nq + 3] = v[3];
    }
    __syncthreads();
    { const int n = tid >> 3, kq = (tid & 7) * 16;
      u32x4 w;
#pragma unroll
      for (int e = 0; e < 4; ++e) w[e] = f2f8x4(tile[(kq + 4 * e) * 65 + n], tile[(kq + 4 * e + 1) * 65 + n], tile[(kq + 4 * e + 2) * 65 + n], tile[(kq + 4 * e + 3) * 65 + n]);
      *reinterpret_cast<u32x4*>(dst + (size_t)(drow0 + n) * ldd + k0 + kq) = w; }
    __syncthreads();
}

__device__ __forceinline__ void fold_unit(CP p, int u, char* lds) {
    const int l = u >> 6, g = (u >> 4) & 3, kp = u & 15, tid = otid();
    float* T = (float*)lds;
    float* wt = T + 128 * 128;
    for (int i = tid; i < 128 * 128; i += NTHREADS) {
        const int c = i >> 7, j = i & 127, m = j >> 1;
        float v;
        if (j == 0) v = 1.f; else if (j == 1) v = (c & 1) ? -1.f : 1.f;
        else { const float x = (float)((m * c) & 127) / 64.f; v = (j & 1) ? -sinpif(x) : cospif(x); }
        T[i] = v * 0.088388347648318440f;
    }
    const float* W = p->in[8] + (size_t)l * 2048 * INC + OFF_D + g * 128;
    for (int kt = 2 * kp; kt < 2 * kp + 2; ++kt) {
    for (int i = tid; i < 64 * 32; i += NTHREADS) {
        const int kk = i >> 5, cq = (i & 31) * 4;
        const f32x4 v = *reinterpret_cast<const f32x4*>(W + (size_t)(kt * 64 + kk) * INC + cq);
        wt[kk * 129 + cq] = v[0]; wt[kk * 129 + cq + 1] = v[1]; wt[kk * 129 + cq + 2] = v[2]; wt[kk * 129 + cq + 3] = v[3];
    }
    __syncthreads();
    unsigned char* Bt = (unsigned char*)(p->ws + WS_BTIN) + (size_t)l * INCP * 2048;
    const int k = tid & 63, jb = tid >> 6;
    float acc[16];
#pragma unroll
    for (int i = 0; i < 16; ++i) acc[i] = 0.f;
#pragma unroll 4
    for (int c = 0; c < 128; ++c) {
        const float w = wt[k * 129 + c]; const f32x4* Tr = reinterpret_cast<const f32x4*>(T + c * 128 + jb * 16);
#pragma unroll
        for (int q = 0; q < 4; ++q) { const f32x4 t = Tr[q]; acc[4 * q] += w * t[0]; acc[4 * q + 1] += w * t[1]; acc[4 * q + 2] += w * t[2]; acc[4 * q + 3] += w * t[3]; }
    }
#pragma unroll
    for (int i = 0; i < 16; ++i) Bt[(size_t)(OFF_D + g * 128 + jb * 16 + i) * 2048 + kt * 64 + k] = f2f8(acc[i] * 64.f);
    __syncthreads();
    }
}

__device__ __forceinline__ void s5_tables(CP p, int idx) {
    const int pp = idx & 63, g = (idx >> 6) & 31, dir = (idx >> 11) & 1, l = idx >> 12;
    const size_t ldg = ((size_t)l * 2 + dir) * 32 + g;
    const float lr = p->in[15][ldg * 64 + pp], li = p->in[16][ldg * 64 + pp], dt = expf(p->in[17][ldg]);
    const float er = expf(lr * dt); float sn, cs; sincosf(li * dt, &sn, &cs);
    const float br_ = er * cs, bi_ = er * sn;
    float Lr = br_, Li = bi_;
#pragma unroll
    for (int s = 0; s < 6; ++s) { const float nr = Lr * Lr - Li * Li, ni = 2.f * Lr * Li; Lr = nr; Li = ni; }
    float* LAM = (float*)(p->ws + WS_S5LAM) + (ldg * 64 + pp) * 4;
    LAM[0] = br_; LAM[1] = bi_; LAM[2] = Lr; LAM[3] = Li;
    const float nr = br_ - 1.f, ni = bi_, den = lr * lr + li * li;
    const float fr = (nr * lr + ni * li) / den, fi = (ni * lr - nr * li) / den;
    bf16_t* BM = (bf16_t*)(p->ws + WS_S5BM) + ldg * 128 * 16;
    const float* Bre = p->in[18] + (ldg * 64 + pp) * 16; const float* Bim = p->in[19] + (ldg * 64 + pp) * 16;
    for (int h = 0; h < 16; ++h) {
        const float xr = Bre[h], xi = Bim[h];
        BM[(size_t)pp * 16 + h] = f2bf(fr * xr - fi * xi);
        BM[(size_t)(64 + pp) * 16 + h] = f2bf(fr * xi + fi * xr);
    }
    bf16_t* CM = (bf16_t*)(p->ws + WS_S5CM) + ((size_t)l * 32 + g) * 16 * 256;
    const float* Cre = p->in[20] + ldg * 16 * 64; const float* Cim = p->in[21] + ldg * 16 * 64;
    for (int h = 0; h < 16; ++h) {
        CM[(size_t)h * 256 + dir * 128 + 2 * pp] = f2bf(Cre[h * 64 + pp]);
        CM[(size_t)h * 256 + dir * 128 + 2 * pp + 1] = f2bf(-Cim[h * 64 + pp]);
    }
}

__device__ __forceinline__ void prologue(CP p, char* lds) {
    const int G = gridDim.x, bid = obid(), tid = otid();
    { const int idx = bid * NTHREADS + tid;
      if (idx < 8192) { float2* TW = (float2*)(p->ws + WS_TW); const float x = (float)idx / 8192.f; TW[idx] = make_float2(cospif(x), -sinpif(x)); }
      for (int i = idx; i < 8192; i += G * NTHREADS) s5_tables(p, i); }
    for (int u = bid; u < 384; u += G) adaln_unit(p, u, lds);
    for (int u = bid; u < 128; u += G) fold_unit(p, u, lds);
    for (int l = 0; l < 2; ++l) {
        { const float* src = p->in[8] + (size_t)l * 2048 * INC; unsigned char* dst = (unsigned char*)(p->ws + WS_BTIN) + (size_t)l * INCP * 2048;
          for (int u = bid; u < 16 * 33; u += G) { const int kp = u / 33, nt = u % 33;
              for (int kt = 2 * kp; kt < 2 * kp + 2; ++kt) cvt_tile_f8(src, INC, kt * 64, nt * 64, dst, nt * 64, 2048, 64.f, lds); } }
        { const float* src = p->in[10] + (size_t)l * 384 * 768; bf16_t* dst = (bf16_t*)(p->ws + WS_BTUQ) + (size_t)l * 768 * 384;
          for (int u = bid; u < 6 * 12; u += G) { const int kt = u / 12, nt = u % 12; cvt_tile(src, 768, kt * 64, nt * 64, dst, nt * 64, 384, p->in[9] + l * 384, lds); } }
        { const float* src = p->in[12] + (size_t)l * 128 * 1024; bf16_t* dst = (bf16_t*)(p->ws + WS_BTUKV) + (size_t)l * 1024 * 256;
          for (int u = bid; u < 2 * 16; u += G) { const int kt = u / 16, nt = u % 16; cvt_tile(src, 1024, kt * 64, nt * 64, dst, nt * 64, 256, p->in[11] + l * 128, lds); }
          for (int i = bid * NTHREADS + tid; i < 1024 * 16; i += G * NTHREADS) { const int n = i >> 4, kq = (i & 15) * 8; *reinterpret_cast<u32x4*>(dst + (size_t)n * 256 + 128 + kq) = (u32x4){0u, 0u, 0u, 0u}; } }
        { const float* src = p->in[23] + (size_t)l * 512 * 1024; bf16_t* dst = (bf16_t*)(p->ws + WS_BTGLU) + (size_t)l * 1024 * 512;
          for (int u = bid; u < 8 * 16; u += G) { const int kt = u / 16, nt = u % 16, n0 = nt * 64;
              const int drow = n0 < 512 ? (n0 >> 7) * 256 + (n0 & 127) : ((n0 - 512) >> 7) * 256 + 128 + (n0 & 127);
              cvt_tile(src, 1024, kt * 64, n0, dst, drow, 512, nullptr, lds); } }
        { const float* src = p->in[24] + (size_t)l * 2048 * 2048; unsigned char* dst = (unsigned char*)(p->ws + WS_BTOUT) + (size_t)l * 2048 * 2048;
          for (int u = bid; u < 16 * 32; u += G) { const int kp = u / 32, nt = u % 32;
              for (int kt = 2 * kp; kt < 2 * kp + 2; ++kt) cvt_tile_f8(src, 2048, kt * 64, nt * 64, dst, nt * 64, 2048, kt < 16 ? 16.f : (kt < 24 ? 512.f : 2048.f), lds); } }
    }
    for (int u = bid; u < 32 * 2 * 256; u += G) {
        const int le = u >> 9, which = (u >> 8) & 1, t = u & 255, kt = t >> 4, nt = t & 15, n0 = nt * 64;
        const float* src = p->in[27 + which] + (size_t)le * 2048 * 1024; unsigned char* dst = (unsigned char*)(p->ws + WS_BTGU) + (size_t)le * 2048 * 2048;
        cvt_tile_f8w(src, 1024, kt * 128, n0, dst, (n0 >> 7) * 256 + which * 128 + (n0 & 127), 2048, 64.f, lds);
    }
    for (int u = bid; u < 32 * 256; u += G) {
        const int le = u >> 8, t = u & 255, kt = t >> 5, nt = t & 31;
        const float* src = p->in[29] + (size_t)le * 1024 * 2048; unsigned char* dst = (unsigned char*)(p->ws + WS_BTDN) + (size_t)le * 2048 * 1024;
        cvt_tile_f8w(src, 2048, kt * 128, nt * 64, dst, nt * 64, 1024, 32.f, lds);
    }
}

struct RowVals { f32x4 v[8]; };
__device__ __forceinline__ void row_load(RowVals& x, const float* __restrict__ src, int lane) {
#pragma unroll
    for (int i = 0; i < 8; ++i) x.v[i] = *reinterpret_cast<const f32x4*>(src + lane * 4 + 256 * i);
}
__device__ __forceinline__ float row_rstd(const RowVals& x) {
    float s = 0.f;
#pragma unroll
    for (int i = 0; i < 8; ++i) s += x.v[i][0] * x.v[i][0] + x.v[i][1] * x.v[i][1] + x.v[i][2] * x.v[i][2] + x.v[i][3] * x.v[i][3];
    s = wave_sum(s);
    return rsqrtf(s * (1.f / 2048.f) + RMS_EPS);
}
__device__ __forceinline__ void row_modulate_store_f8(RowVals& x, float rstd, const float* __restrict__ g, const float* __restrict__ sh, const float* __restrict__ sc, unsigned char* __restrict__ dst, int lane) {
#pragma unroll
    for (int i = 0; i < 8; ++i) {
        const int c = lane * 4 + 256 * i;
        const f32x4 gg = *reinterpret_cast<const f32x4*>(g + c), s1 = *reinterpret_cast<const f32x4*>(sc + c), s0 = *reinterpret_cast<const f32x4*>(sh + c);
        f32x4 h;
#pragma unroll
        for (int j = 0; j < 4; ++j) h[j] = (x.v[i][j] * rstd * gg[j]) * (1.f + s1[j]) + s0[j];
        x.v[i] = h;
        *reinterpret_cast<unsigned*>(dst + c) = f2f8x4(h[0], h[1], h[2], h[3]);
    }
}
__device__ __forceinline__ void row_modulate_store(RowVals& x, float rstd, const float* __restrict__ g, const float* __restrict__ sh, const float* __restrict__ sc, bf16_t* __restrict__ dst, int lane) {
#pragma unroll
    for (int i = 0; i < 8; ++i) {
        const int c = lane * 4 + 256 * i;
        const f32x4 gg = *reinterpret_cast<const f32x4*>(g + c), s1 = *reinterpret_cast<const f32x4*>(sc + c), s0 = *reinterpret_cast<const f32x4*>(sh + c);
        f32x4 h;
#pragma unroll
        for (int j = 0; j < 4; ++j) h[j] = (x.v[i][j] * rstd * gg[j]) * (1.f + s1[j]) + s0[j];
        x.v[i] = h;
        u32x2 w = {cvtpk(h[0], h[1]), cvtpk(h[2], h[3])};
        *reinterpret_cast<u32x2*>(dst + c) = w;
    }
}
__device__ __forceinline__ void row_moe_combine(RowVals& x, const unsigned char* __restrict__ y0, const unsigned char* __restrict__ y1, float gw0, float gw1, const float* __restrict__ g2, int lane) {
    gw0 *= (1.f / 16.f); gw1 *= (1.f / 16.f);
#pragma unroll
    for (int i = 0; i < 8; ++i) {
        const int c = lane * 4 + 256 * i;
        const int a = *reinterpret_cast<const int*>(y0 + c), b = *reinterpret_cast<const int*>(y1 + c);
        const f32x4 gg = *reinterpret_cast<const f32x4*>(g2 + c);
        const f32x2 a01 = __builtin_amdgcn_cvt_pk_f32_fp8(a, false), a23 = __builtin_amdgcn_cvt_pk_f32_fp8(a, true), b01 = __builtin_amdgcn_cvt_pk_f32_fp8(b, false), b23 = __builtin_amdgcn_cvt_pk_f32_fp8(b, true);
        x.v[i][0] += gg[0] * (gw0 * a01[0] + gw1 * b01[0]);
        x.v[i][1] += gg[1] * (gw0 * a01[1] + gw1 * b01[1]);
        x.v[i][2] += gg[2] * (gw0 * a23[0] + gw1 * b23[0]);
        x.v[i][3] += gg[3] * (gw0 * a23[1] + gw1 * b23[1]);
    }
}
__device__ __forceinline__ bf16_t* xres_row(CP p, int row) {
    const int b = row / NTOK, t = row % NTOK;
    return t < CTX ? (bf16_t*)(p->ws + WS_CTXX) + (size_t)(b * CTX + t) * DM : (bf16_t*)(p->out + (size_t)(b * SEQ + t - CTX) * DM + DM / 2);
}
__device__ __forceinline__ void row_load_bf(RowVals& x, const bf16_t* __restrict__ src, int lane) {
#pragma unroll
    for (int i = 0; i < 8; ++i) { const u32x2 w = *reinterpret_cast<const u32x2*>(src + lane * 4 + 256 * i); x.v[i] = (f32x4){bflo(w[0]), bfhi(w[0]), bflo(w[1]), bfhi(w[1])}; }
}
__device__ __forceinline__ void row_store_bf(const RowVals& x, bf16_t* __restrict__ dst, int lane) {
#pragma unroll
    for (int i = 0; i < 8; ++i) { u32x2 w = {cvtpk(x.v[i][0], x.v[i][1]), cvtpk(x.v[i][2], x.v[i][3])}; *reinterpret_cast<u32x2*>(dst + lane * 4 + 256 * i) = w; }
}
__device__ __forceinline__ const float* xin_row(CP p, int row) {
    const int b = row / NTOK, t = row % NTOK;
    return t < CTX ? p->in[2] + (size_t)(b * CTX + t) * DM : p->in[0] + (size_t)(b * SEQ + t - CTX) * DM;
}
__device__ __forceinline__ const float* mod_row(CP p, int l, int row) {
    const int b = row / NTOK, t = row % NTOK;
    return (const float*)(p->ws + WS_MOD) + ((size_t)l * 3 + (t < CTX ? 2 : b)) * 12288;
}

__device__ __forceinline__ void phase_norm1(CP p, int l) {
    const int tid_ = otid(), wid = tid_ >> 6, lane = tid_ & 63;
    bf16_t* HL = (bf16_t*)(p->ws + WS_HL);
    for (int row = obid() * 8 + wid; row < MR; row += gridDim.x * 8) {
        RowVals x;
        if (l == 0) row_load(x, xin_row(p, row), lane);
        else {
            bf16_t* xr = xres_row(p, row); row_load_bf(x, xr, lane);
            const unsigned char* Y = (const unsigned char*)(p->ws + WS_Y) + (size_t)row * 2 * DM; const float* GT = (const float*)(p->ws + WS_GATE) + (size_t)row * 2;
            row_moe_combine(x, Y, Y + DM, GT[0], GT[1], mod_row(p, 0, row) + 5 * 2048, lane);
            row_store_bf(x, xr, lane);
        }
        const float rstd = row_rstd(x); const float* md = mod_row(p, l, row);
        row_modulate_store_f8(x, rstd, p->in[6] + l * DM, md, md + 2048, (unsigned char*)HL + (size_t)row * DM, lane);
    }
}
__device__ __forceinline__ void phase_final(CP p) {
    const int tid_ = otid(), wid = tid_ >> 6, lane = tid_ & 63;
    for (int rr = obid() * 8 + wid; rr < NBATCH * SEQ; rr += gridDim.x * 8) {
        const int b = rr / SEQ, row = b * NTOK + CTX + (rr % SEQ);
#if DBG_STOP && DBG_STOP < 8
        {
            const bf16_t* HL = (const bf16_t*)(p->ws + WS_HL); const bf16_t* PL = (const bf16_t*)(p->ws + WS_PL); const bf16_t* A2 = (const bf16_t*)(p->ws + WS_A2);
            const bf16_t* QM = (const bf16_t*)(p->ws + WS_QM); const bf16_t* KM = (const bf16_t*)(p->ws + WS_KM); const bf16_t* VM = (const bf16_t*)(p->ws + WS_VM);
            const bf16_t* MIX = (const bf16_t*)(p->ws + WS_MIX); const bf16_t* YB = (const bf16_t*)(p->ws + WS_YB);
            const float* S5E = (const float*)(p->ws + WS_S5E); const float* S5H = (const float*)(p->ws + WS_S5H);
            const int rowc = b * NTOK + (rr % SEQ) % CTX;
            for (int c = lane; c < DM; c += 64) {
                float v = 0.f; const size_t flat = ((size_t)rr * DM + c) % 4259840;
                if (DBG_STOP == 2) v = bf2f(HL[(size_t)row * DM + c]) + bf2f(HL[(size_t)rowc * DM + c]);
                if (DBG_STOP == 3) v = bf2f(PL[(size_t)row * INC + c]) + bf2f(PL[(size_t)row * INC + c + 576]) + bf2f(PL[(size_t)rowc * INC + c]);
                if (DBG_STOP == 4) v = (DBG_TAP == 0 ? bf2f(MIX[(size_t)row * DM + 1536 + (c & 511)]) + bf2f(MIX[(size_t)rowc * DM + 1536 + (c & 511)]) : 0.f)
                                     + (DBG_TAP == 1 ? bf2f(A2[(size_t)row * 640 + c % 640]) + bf2f(PL[(size_t)row * INC + c + 576]) + bf2f(KM[(size_t)row * 768 + (c & 3) * 192 + 128 + ((c >> 2) & 63)]) : 0.f)
                                     + (DBG_TAP == 2 ? S5E[flat] : 0.f);
                if (DBG_STOP == 5) v = (DBG_TAP == 0 ? bf2f(QM[(size_t)row * 768 + c % 768]) + bf2f(KM[(size_t)row * 768 + c % 768]) + bf2f(VM[(size_t)row * 512 + (c & 511)]) : 0.f) + (DBG_TAP == 1 ? S5H[flat] : 0.f);
                if (DBG_STOP == 6) v = (DBG_TAP == 0 ? bf2f(MIX[(size_t)row * DM + (c & 511)]) : 0.f) + (DBG_TAP == 1 ? bf2f(MIX[(size_t)row * DM + 512 + (c & 511)]) : 0.f) + (DBG_TAP == 2 ? bf2f(YB[(size_t)row * 512 + (c & 511)]) : 0.f)
                                     + (DBG_TAP == 3 ? bf2f(MIX[(size_t)rowc * DM + (c & 1023)]) + bf2f(YB[(size_t)rowc * 512 + (c & 511)]) : 0.f);
                if (DBG_STOP == 7) v = bf2f(MIX[(size_t)row * DM + 1024 + (c & 511)]) + bf2f(MIX[(size_t)rowc * DM + 1024 + (c & 511)]);
                p->out[(size_t)rr * DM + c] = v;
            }
            continue;
        }
#endif
        RowVals x; float* xr = p->out + (size_t)rr * DM; row_load_bf(x, xres_row(p, row), lane);
        const unsigned char* Y = (const unsigned char*)(p->ws + WS_Y) + (size_t)row * 2 * DM; const float* GT = (const float*)(p->ws + WS_GATE) + (size_t)row * 2;
        if (!DBG_STOP) row_moe_combine(x, Y, Y + DM, GT[0], GT[1], mod_row(p, 1, row) + 5 * 2048, lane);
        const float rstd = row_rstd(x);
#pragma unroll
        for (int i = 0; i < 8; ++i) {
            const int c = lane * 4 + 256 * i; const f32x4 gg = *reinterpret_cast<const f32x4*>(p->in[30] + c);
            f32x4 o; for (int j = 0; j < 4; ++j) o[j] = x.v[i][j] * rstd * gg[j];
            *reinterpret_cast<f32x4*>(xr + c) = o;
        }
    }
}
struct RouteSel { int e1, e2; float g1, g2; };
__device__ __forceinline__ RouteSel route_select(const float (&lg)[16], const float (&bias)[16]) {
    float sc[16], sel[16];
#pragma unroll
    for (int e = 0; e < 16; ++e) { sc[e] = sigmoid_f(lg[e]); sel[e] = sc[e] + bias[e]; }
    int grp = 0; float best = -1e30f;
#pragma unroll
    for (int g = 0; g < 4; ++g) {
        const float a = sel[4 * g], b = sel[4 * g + 1], c = sel[4 * g + 2], d = sel[4 * g + 3];
        const float m1 = fmaxf(fmaxf(a, b), fmaxf(c, d));
        const float hi1 = fmaxf(a, b), lo1 = fminf(a, b), hi2 = fmaxf(c, d), lo2 = fminf(c, d);
        const float m2 = fmaxf(fminf(hi1, hi2), fmaxf(lo1, lo2));
        const float gs = m1 + m2;
        if (gs > best) { best = gs; grp = g; }
    }
    float s4[4], c4[4];
#pragma unroll
    for (int i = 0; i < 4; ++i) { s4[i] = 0.f; c4[i] = 0.f; }
#pragma unroll
    for (int g = 0; g < 4; ++g)
#pragma unroll
        for (int i = 0; i < 4; ++i) if (g == grp) { s4[i] = sel[4 * g + i]; c4[i] = sc[4 * g + i]; }
    int i1 = 0; float v1 = s4[0];
#pragma unroll
    for (int i = 1; i < 4; ++i) if (s4[i] > v1) { v1 = s4[i]; i1 = i; }
    int i2 = -1; float v2 = -1e30f;
#pragma unroll
    for (int i = 0; i < 4; ++i) if (i != i1 && s4[i] > v2) { v2 = s4[i]; i2 = i; }
    float g1v = 0.f, g2v = 0.f;
#pragma unroll
    for (int i = 0; i < 4; ++i) { if (i == i1) g1v = c4[i]; if (i == i2) g2v = c4[i]; }
    const float inv = 1.f / (g1v + g2v);
    RouteSel r; r.e1 = grp * 4 + i1; r.e2 = grp * 4 + i2; r.g1 = g1v * inv; r.g2 = g2v * inv; return r;
}
__device__ __forceinline__ void phase_norm2(CP p, int l, char* lds) {
    const int tid = otid(), wid = tid >> 6, lane = tid & 63;
    float* rwT = (float*)lds;
    for (int i = tid; i < 2048 * 16; i += NTHREADS) rwT[(i & 15) * 2052 + (i >> 4)] = p->in[25][i];
    LAS unsigned* lcnt = (LAS unsigned*)(lds + 131584);
    LAS unsigned* lbase = (LAS unsigned*)(lds + 131584 + 64);
    LAS unsigned* route = (LAS unsigned*)(lds + 131584 + 128) + wid * 64;
    if (tid < 16) lcnt[tid] = 0u;
    __syncthreads();
    unsigned char* HL8 = (unsigned char*)(p->ws + WS_HL);
    unsigned* CNT = (unsigned*)(p->ws + WS_CTL) + CW_CNT + l * 16 * 16;
    int* LIST = (int*)(p->ws + WS_LIST); float* GT = (float*)(p->ws + WS_GATE);
    float bias[16];
#pragma unroll
    for (int e = 0; e < 16; ++e) bias[e] = p->in[26][e];
    const int stride = gridDim.x * 8, first = obid() * 8 + wid;
    int it = 0;
    for (int row = first; row < MR; row += 2 * stride, it += 2) {
        const int rowb = row + stride;
        const bool va = !(l == 1 && (row % NTOK) < CTX), vb = rowb < MR && !(l == 1 && (rowb % NTOK) < CTX);
        RowVals xa, xb;
        if (va) { row_load_bf(xa, xres_row(p, row), lane); const float rstd = row_rstd(xa); const float* md = mod_row(p, l, row);
                  row_modulate_store_f8(xa, rstd, p->in[7] + l * DM, md + 3 * 2048, md + 4 * 2048, HL8 + (size_t)row * DM, lane); }
        else {
#pragma unroll
            for (int i = 0; i < 8; ++i) xa.v[i] = (f32x4){0.f, 0.f, 0.f, 0.f}; }
        if (vb) { row_load_bf(xb, xres_row(p, rowb), lane); const float rstd = row_rstd(xb); const float* md = mod_row(p, l, rowb);
                  row_modulate_store_f8(xb, rstd, p->in[7] + l * DM, md + 3 * 2048, md + 4 * 2048, HL8 + (size_t)rowb * DM, lane); }
        else {
#pragma unroll
            for (int i = 0; i < 8; ++i) xb.v[i] = (f32x4){0.f, 0.f, 0.f, 0.f}; }
        float lga[16], lgb[16];
#pragma unroll
        for (int e = 0; e < 16; ++e) {
            float sa = 0.f, sb = 0.f;
#pragma unroll
            for (int i = 0; i < 8; ++i) { const f32x4 w = *reinterpret_cast<const f32x4*>(rwT + e * 2052 + lane * 4 + 256 * i);
                sa += xa.v[i][0] * w[0] + xa.v[i][1] * w[1] + xa.v[i][2] * w[2] + xa.v[i][3] * w[3];
                sb += xb.v[i][0] * w[0] + xb.v[i][1] * w[1] + xb.v[i][2] * w[2] + xb.v[i][3] * w[3]; }
            lga[e] = sa; lgb[e] = sb;
        }
#pragma unroll
        for (int e = 0; e < 16; ++e) { lga[e] = wave_sum(lga[e]); lgb[e] = wave_sum(lgb[e]); }
        const RouteSel ra = route_select(lga, bias), rb = route_select(lgb, bias);
        if (lane == 0) {
            if (va) { const unsigned p1 = __hip_atomic_fetch_add(lcnt + ra.e1, 1u, __ATOMIC_RELAXED, __HIP_MEMORY_SCOPE_WORKGROUP), p2 = __hip_atomic_fetch_add(lcnt + ra.e2, 1u, __ATOMIC_RELAXED, __HIP_MEMORY_SCOPE_WORKGROUP);
                      route[it * 2] = (unsigned)ra.e1 | (p1 << 8); route[it * 2 + 1] = (unsigned)ra.e2 | (p2 << 8); st_wt(GT + (size_t)row * 2, ra.g1); st_wt(GT + (size_t)row * 2 + 1, ra.g2); }
            else route[it * 2] = 0xffffffffu;
            if (vb) { const unsigned p1 = __hip_atomic_fetch_add(lcnt + rb.e1, 1u, __ATOMIC_RELAXED, __HIP_MEMORY_SCOPE_WORKGROUP), p2 = __hip_atomic_fetch_add(lcnt + rb.e2, 1u, __ATOMIC_RELAXED, __HIP_MEMORY_SCOPE_WORKGROUP);
                      route[it * 2 + 2] = (unsigned)rb.e1 | (p1 << 8); route[it * 2 + 3] = (unsigned)rb.e2 | (p2 << 8); st_wt(GT + (size_t)rowb * 2, rb.g1); st_wt(GT + (size_t)rowb * 2 + 1, rb.g2); }
            else route[it * 2 + 2] = 0xffffffffu;
        }
    }
    __syncthreads();
    if (tid < 16) lbase[tid] = atomicAdd(&CNT[tid * 16], lcnt[tid]);
    __syncthreads();
    if (lane < it) {
        const int row = first + lane * stride; const unsigned r1 = route[lane * 2];
        if (r1 != 0xffffffffu) { const unsigned r2 = route[lane * 2 + 1];
            st_wt(LIST + (size_t)(r1 & 255u) * MR + lbase[r1 & 255u] + (r1 >> 8), row * 2);
            st_wt(LIST + (size_t)(r2 & 255u) * MR + lbase[r2 & 255u] + (r2 >> 8), row * 2 + 1); }
    }
    __syncthreads();
}

__device__ __forceinline__ void phase_post(CP p, int l) {
    const int tid_ = otid(), wid = tid_ >> 6, lane = tid_ & 63;
    bf16_t* PL = (bf16_t*)(p->ws + WS_PL); bf16_t* A2 = (bf16_t*)(p->ws + WS_A2); unsigned char* K8M = (unsigned char*)(p->ws + WS_K8M); unsigned char* K8G = (unsigned char*)(p->ws + WS_K8G);
    const float gq0 = p->in[13][l * 128 + lane], gq1 = p->in[13][l * 128 + 64 + lane], gk0 = p->in[14][l * 128 + lane], gk1 = p->in[14][l * 128 + 64 + lane];
    const float invm = __builtin_amdgcn_exp2f(-(float)(lane & 15) * (13.287712379549449f / 16.f) - 2.651496129472319f), invg = __builtin_amdgcn_exp2f(-(float)(lane & 31) * (13.287712379549449f / 32.f) - 2.651496129472319f);
    for (int row = obid() * 8 + wid; row < MR; row += gridDim.x * 8) {
        const int t = row % NTOK; const bool lat = t >= CTX; const int s = t - CTX;
        const float rp = (float)(s >> 6), cp = (float)(s & 63);
        bf16_t* pr = PL + (size_t)row * INC;
        float ql[6], kv[2], kr, hq[6][2];
#pragma unroll
        for (int i = 0; i < 6; ++i) ql[i] = bf2f(pr[lane + 64 * i]);
#pragma unroll
        for (int i = 0; i < 2; ++i) kv[i] = bf2f(pr[384 + lane + 64 * i]);
        kr = bf2f(pr[512 + lane]);
#pragma unroll
        for (int h = 0; h < 6; ++h) { hq[h][0] = bf2f(pr[OFF_B + h * 128 + lane]); hq[h][1] = bf2f(pr[OFF_B + h * 128 + 64 + lane]); }
        float ss[8];
        ss[0] = 0.f;
#pragma unroll
        for (int i = 0; i < 6; ++i) ss[0] += ql[i] * ql[i];
        ss[1] = kv[0] * kv[0] + kv[1] * kv[1];
#pragma unroll
        for (int h = 0; h < 6; ++h) ss[2 + h] = hq[h][0] * hq[h][0] + hq[h][1] * hq[h][1];
#pragma unroll
        for (int e = 0; e < 8; ++e) ss[e] = wave_sum(ss[e]);
        const float rq = rsqrtf(ss[0] * (1.f / 384.f) + RMS_EPS), rk = rsqrtf(ss[1] * (1.f / 128.f) + RMS_EPS);
        bf16_t* a2 = A2 + (size_t)row * 640;
#pragma unroll
        for (int i = 0; i < 6; ++i) a2[lane + 64 * i] = f2bf(ql[i] * rq);
#pragma unroll
        for (int i = 0; i < 2; ++i) a2[384 + lane + 64 * i] = f2bf(kv[i] * rk);
        a2[512 + lane] = 0; a2[576 + lane] = 0;
        { float o = kr;
          if (lat) { const float other = half_other(kr, lane < 32); const float rev = ((lane & 31) < 16 ? rp : cp) * invm; const float sn = __builtin_amdgcn_sinf(rev), cs = __builtin_amdgcn_cosf(rev);
              o = lane < 32 ? kr * cs - other * sn : kr * cs + other * sn; }
          const unsigned char ob = f2f8(o); unsigned char* km = K8M + (size_t)row * 768 + 128 + lane;
          km[0] = ob; km[192] = ob; km[384] = ob; km[576] = ob; }
        float sn = 0.f, cs = 1.f;
        if (lat) { const float rev = (lane < 32 ? rp : cp) * invg; sn = __builtin_amdgcn_sinf(rev); cs = __builtin_amdgcn_cosf(rev); }
#pragma unroll
        for (int h = 0; h < 6; ++h) {
            const float r = rsqrtf(ss[2 + h] * (1.f / 128.f) + RMS_EPS);
            const float n1 = hq[h][0] * r * (h < 4 ? gq0 : gk0), n2 = hq[h][1] * r * (h < 4 ? gq1 : gk1);
            const float o1 = n1 * cs - n2 * sn, o2 = n2 * cs + n1 * sn;
#if PROBE_DRY == 3
            if (h < 4 && p->dry) { bf16_t* pw = (bf16_t*)(p->ws + WS_QM) + (size_t)row * INC; pw[OFF_B + h * 128 + lane] = f2bf(o1); pw[OFF_B + h * 128 + 64 + lane] = f2bf(o2); } else
#endif
            if (h < 4) { pr[OFF_B + h * 128 + lane] = f2bf(o1); pr[OFF_B + h * 128 + 64 + lane] = f2bf(o2); }
            else { unsigned char* kg = K8G + (size_t)row * 256 + (h - 4) * 128 + lane; kg[0] = f2f8(o1); kg[64] = f2f8(o2); }
        }
    }
}

constexpr int S5_RS = 272;
__device__ __forceinline__ int s5_scan_chunk(int dir, int tchunk) {
    if (dir == 0) return tchunk;
    return tchunk < 4 ? 3 - tchunk : 263 - tchunk;
}
__device__ __forceinline__ int s5_unit_group(int u) { const int g5 = u & 31; return (g5 >> 3) | ((g5 & 7) << 2); }
__device__ __forceinline__ bf16x8 ld16_wt(const bf16_t* ptr) {
    const unsigned long long* q8 = reinterpret_cast<const unsigned long long*>(ptr);
    union { unsigned long long q[2]; bf16x8 v; } cv; cv.q[0] = __hip_atomic_load(q8, __ATOMIC_RELAXED, __HIP_MEMORY_SCOPE_AGENT); cv.q[1] = __hip_atomic_load(q8 + 1, __ATOMIC_RELAXED, __HIP_MEMORY_SCOPE_AGENT); return cv.v;
}
template <int MODE>
__device__ __forceinline__ void phase_s5(CP p, int l, char* lds) {
    const int tid = otid(), w = tid >> 6, lane = tid & 63, dir = w >> 2, ch = w & 3, r32 = lane & 31, hi = lane >> 5, fr = lane & 15, fq = lane >> 4;
    const int G = gridDim.x;
    const bf16_t* PL = (const bf16_t*)(p->ws + WS_PL);
    char* myl = lds + w * (64 * S5_RS);
    int cur_bg = -1;
    bf16x8 bfr[4], cfr[8]; float lr = 0.f, li = 0.f, dpar = 0.f;
    bf16x8 afrN[2]; float h0rN = 0.f, h0iN = 0.f; bf16_t uvN[8];
#define S5_LOADS(U_) do { const int b_ = ((U_) & 63) >> 5, g_ = s5_unit_group(U_), tc4_ = (U_) >> 6, tch_ = tc4_ * 4 + ch, row0_ = b_ * NTOK + tch_ * 64; \
      \
    _Pragma("unroll") for (int mb = 0; mb < 2; ++mb) { const unsigned long long* q8_ = reinterpret_cast<const unsigned long long*>(PL + (size_t)(row0_ + mb * 32 + r32) * INC + OFF_C + g_ * 16 + hi * 8); \
        union { unsigned long long q[2]; bf16x8 v; } cv_; cv_.q[0] = __hip_atomic_load(q8_, __ATOMIC_RELAXED, __HIP_MEMORY_SCOPE_AGENT); cv_.q[1] = __hip_atomic_load(q8_ + 1, __ATOMIC_RELAXED, __HIP_MEMORY_SCOPE_AGENT); afrN[mb] = cv_.v; } \
    if (MODE == 1) { const size_t sb_ = ((((size_t)b_ * 2 + dir) * 32 + g_) * NCHUNK + s5_scan_chunk(dir, tch_)) * 128; const float* H0 = (const float*)(p->ws + WS_S5H) + sb_; h0rN = __hip_atomic_load(H0 + lane, __ATOMIC_RELAXED, __HIP_MEMORY_SCOPE_AGENT); h0iN = __hip_atomic_load(H0 + 64 + lane, __ATOMIC_RELAXED, __HIP_MEMORY_SCOPE_AGENT); \
        _Pragma("unroll") for (int q_ = 0; q_ < 8; ++q_) uvN[q_] = __hip_atomic_load(PL + (size_t)(b_ * NTOK + tc4_ * 256 + w * 32 + (q_ >> 2) * 16 + fq * 4 + (q_ & 3)) * INC + OFF_C + g_ * 16 + fr, __ATOMIC_RELAXED, __HIP_MEMORY_SCOPE_AGENT); } } while (0)
    int u = obid();
    if (u < 4160) S5_LOADS(u);
    for (; u < 4160; u += G) {
        const int bg = u & 63, b = bg >> 5, g = s5_unit_group(u), tc4 = u >> 6, tchunk = tc4 * 4 + ch;
        const size_t ldg = ((size_t)l * 2 + dir) * 32 + g;
        if (bg != cur_bg) {
            cur_bg = bg;
            const bf16_t* BM = (const bf16_t*)(p->ws + WS_S5BM) + ldg * 128 * 16;
#pragma unroll
            for (int nb = 0; nb < 4; ++nb) bfr[nb] = ld16_wt(BM + (size_t)(nb * 32 + r32) * 16 + hi * 8);
            const float* LAM = (const float*)(p->ws + WS_S5LAM) + (ldg * 64 + lane) * 4;
            lr = __hip_atomic_load(LAM, __ATOMIC_RELAXED, __HIP_MEMORY_SCOPE_AGENT); li = __hip_atomic_load(LAM + 1, __ATOMIC_RELAXED, __HIP_MEMORY_SCOPE_AGENT);
            if (MODE == 1) {
                const bf16_t* CM = (const bf16_t*)(p->ws + WS_S5CM) + ((size_t)l * 32 + g) * 16 * 256;
#pragma unroll
                for (int ks = 0; ks < 8; ++ks) cfr[ks] = ld16_wt(CM + (size_t)fr * 256 + ks * 32 + fq * 8);
                dpar = p->in[22][l * 512 + g * 16 + fr];
            }
        }
        bf16x8 afr[2] = {afrN[0], afrN[1]}; float hr = h0rN, hi_ = h0iN; bf16_t uv[8];
#pragma unroll
        for (int q_ = 0; q_ < 8; ++q_) uv[q_] = uvN[q_];
        if (u + G < 4160) S5_LOADS(u + G);
#pragma unroll
        for (int mb = 0; mb < 2; ++mb) {
#pragma unroll
            for (int nb = 0; nb < 2; ++nb) {
                f32x16 are = {}, aim = {};
                are = __builtin_amdgcn_mfma_f32_32x32x16_bf16(afr[mb], bfr[nb], are, 0, 0, 0);
                aim = __builtin_amdgcn_mfma_f32_32x32x16_bf16(afr[mb], bfr[nb + 2], aim, 0, 0, 0);
#pragma unroll
                for (int r = 0; r < 16; ++r) *reinterpret_cast<unsigned*>(myl + (mb * 32 + crow(r, hi)) * S5_RS + (nb * 32 + r32) * 4) = cvtpk(are[r], aim[r]);
            }
        }
        asm volatile("s_waitcnt lgkmcnt(0)" ::: "memory");
        if (MODE == 0) { hr = 0.f; hi_ = 0.f; }
#pragma unroll 8
        for (int st = 0; st < 64; ++st) {
            const int t = dir == 0 ? st : 63 - st;
            unsigned* rowp = reinterpret_cast<unsigned*>(myl + t * S5_RS);
            const unsigned bw = rowp[lane]; const float br = bflo(bw), bi = bfhi(bw);
            const float nr = lr * hr - li * hi_ + br, ni = lr * hi_ + li * hr + bi;
            hr = nr; hi_ = ni;
            if (MODE == 1) rowp[lane] = cvtpk(hr, hi_);
        }
        if (MODE == 0) { float* E = (float*)(p->ws + WS_S5E) + ((((size_t)b * 2 + dir) * 32 + g) * NCHUNK + s5_scan_chunk(dir, tchunk)) * 128; E[lane] = hr; E[64 + lane] = hi_; }
        if (MODE == 1) {
            __syncthreads();
            if (!(l == 1 && tc4 == 0)) {
                bf16_t* YB = (bf16_t*)(p->ws + WS_YB);
#pragma unroll
                for (int mb = 0; mb < 2; ++mb) {
                    const int tl = w * 32 + mb * 16, chn = tl >> 6, tin = tl & 63;
                    f32x4 acc = {0.f, 0.f, 0.f, 0.f};
#pragma unroll
                    for (int ks = 0; ks < 8; ++ks) {
                        const int d = ks >> 2;
                        const char* src = lds + (d * 4 + chn) * (64 * S5_RS) + (tin + fr) * S5_RS + ((ks & 3) * 32 + fq * 8) * 2;
                        acc = __builtin_amdgcn_mfma_f32_16x16x32_bf16(*reinterpret_cast<const bf16x8*>(src), cfr[ks], acc, 0, 0, 0);
                    }
#pragma unroll
                    for (int j = 0; j < 4; ++j) {
                        const int row = b * NTOK + tc4 * 256 + tl + fq * 4 + j;
                        const float y = acc[j] + dpar * bf2f(uv[mb * 4 + j]);
                        const float z2 = -2.3022082f * (y + 0.044715f * y * y * y);
                        const float ge = y * __builtin_amdgcn_rcpf(1.f + __builtin_amdgcn_exp2f(z2));
                        const float go = __int_as_float(__builtin_amdgcn_mov_dpp(__float_as_int(ge), 0xB1, 0xF, 0xF, false));
                        if (!(fr & 1)) st_wt(reinterpret_cast<unsigned*>(YB + (size_t)row * 512 + g * 16 + fr), cvtpk(ge, go));
                    }
                }
            }
        }
        __syncthreads();
    }
#undef S5_LOADS
}
__device__ __forceinline__ void phase_s5a_direct(CP p, int l) {
    const int tid = otid(), w = tid >> 6, lane = tid & 63, r32 = lane & 31, hi = lane >> 5;
    const bf16_t* PL = (const bf16_t*)(p->ws + WS_PL);
    const int wg = obid() * 8 + w, nw = gridDim.x * 8;
    int cur = -1;
    bf16x8 bfr[4]; float lr[2], li[2], l4r[2], l4i[2], l5r[2], l5i[2];
    for (int wu = wg; wu < 128 * NCHUNK; wu += nw) {
        const int bdg = wu & 127, tchunk = wu >> 7, g = bdg & 31, dir = (bdg >> 5) & 1, b = bdg >> 6;
        const size_t ldg = ((size_t)l * 2 + dir) * 32 + g;
        if (bdg != cur) {
            cur = bdg;
            const bf16_t* BM = (const bf16_t*)(p->ws + WS_S5BM) + ldg * 128 * 16;
#pragma unroll
            for (int nb = 0; nb < 4; ++nb) bfr[nb] = *reinterpret_cast<const bf16x8*>(BM + (size_t)(nb * 32 + r32) * 16 + hi * 8);
#pragma unroll
            for (int st = 0; st < 2; ++st) {
                const float* LAM = (const float*)(p->ws + WS_S5LAM) + (ldg * 64 + st * 32 + r32) * 4;
                const float a = LAM[0], c = LAM[1]; lr[st] = a; li[st] = c;
                const float r2 = a * a - c * c, i2 = 2.f * a * c, r4 = r2 * r2 - i2 * i2, i4 = 2.f * r2 * i2;
                l4r[st] = r4; l4i[st] = i4; l5r[st] = r4 * a - i4 * c; l5i[st] = r4 * c + i4 * a;
            }
        }
        const int row0 = b * NTOK + tchunk * 64;
        float hr[2] = {0.f, 0.f}, hm[2] = {0.f, 0.f};
#pragma unroll
        for (int mb = 0; mb < 2; ++mb) {
            const int j = mb * 32 + r32, tok = dir == 0 ? j : 63 - j;
            const bf16x8 afr = *reinterpret_cast<const bf16x8*>(PL + (size_t)(row0 + tok) * INC + OFF_C + g * 16 + hi * 8);
            f32x16 acc[4];
#pragma unroll
            for (int nb = 0; nb < 4; ++nb) { f32x16 z = {}; acc[nb] = __builtin_amdgcn_mfma_f32_32x32x16_bf16(afr, bfr[nb], z, 0, 0, 0); }
#pragma unroll
            for (int r = 0; r < 16; ++r) {
                const bool big = (r & 3) == 0 && !(mb == 0 && r == 0);
#pragma unroll
                for (int st = 0; st < 2; ++st) {
                    const float ar = big ? l5r[st] : lr[st], ai = big ? l5i[st] : li[st];
                    const float nr = ar * hr[st] - ai * hm[st] + acc[st][r], ni = ar * hm[st] + ai * hr[st] + acc[2 + st][r];
                    hr[st] = nr; hm[st] = ni;
                }
            }
        }
        float er[2], ei[2];
#pragma unroll
        for (int st = 0; st < 2; ++st) {
            const float xr = hi == 0 ? l4r[st] * hr[st] - l4i[st] * hm[st] : hr[st], xi = hi == 0 ? l4r[st] * hm[st] + l4i[st] * hr[st] : hm[st];
            er[st] = half_sum(xr); ei[st] = half_sum(xi);
        }
        float* E = (float*)(p->ws + WS_S5E) + ((((size_t)b * 2 + dir) * 32 + g) * NCHUNK + s5_scan_chunk(dir, tchunk)) * 128;
        E[hi * 32 + r32] = hi == 0 ? er[0] : er[1]; E[64 + hi * 32 + r32] = hi == 0 ? ei[0] : ei[1];
    }
}
__device__ __forceinline__ void s5_carry_unit(CP p, int l, int u, char* lds) {
    const int tid = otid(), g = u & 31, dir = (u >> 5) & 1, b = u >> 6;
    const size_t sbase = (((size_t)b * 2 + dir) * 32 + g) * NCHUNK * 128;
    const float* E = (const float*)(p->ws + WS_S5E) + sbase; float* H = (float*)(p->ws + WS_S5H) + sbase;
    float* el = (float*)lds;
    for (int i = tid; i < NCHUNK * 128 / 4; i += NTHREADS) reinterpret_cast<f32x4*>(el)[i] = reinterpret_cast<const f32x4*>(E)[i];
    __syncthreads();
    if (tid < 64) {
        const float* LAM = (const float*)(p->ws + WS_S5LAM) + ((((size_t)l * 2 + dir) * 32 + g) * 64 + tid) * 4;
        const float Lr = LAM[2], Li = LAM[3];
        float hr = 0.f, hi_ = 0.f;
        for (int c = 0; c < NCHUNK; ++c) {
            H[c * 128 + tid] = hr; H[c * 128 + 64 + tid] = hi_;
            const float er = el[c * 128 + tid], ei = el[c * 128 + 64 + tid];
            const float nr = Lr * hr - Li * hi_ + er, ni = Lr * hi_ + Li * hr + ei;
            hr = nr; hi_ = ni;
        }
    }
    __syncthreads();
}

__device__ __forceinline__ void fft_unit(CP p, int b, int t0, int LOGN, int g, int m, char* lds) {
    const int tid = otid(), N = 1 << LOGN;
    float2* x = (float2*)lds;
    const unsigned* GT = (const unsigned*)(p->ws + WS_GT) + ((size_t)(b * 4 + g) * 64 + m) * NTOK + t0;
    for (int n = tid; n < N; n += NTHREADS) { const unsigned w = GT[n]; x[n] = make_float2(bflo(w), bfhi(w)); }
    __syncthreads();
    const float2* TW = (const float2*)(p->ws + WS_TW);
    const int tsh = 14 - LOGN;
    for (int s = 0; s < LOGN; ++s) {
        const int hb = LOGN - 1 - s, half = 1 << hb;
        float2 w = TW[((tid & (half - 1)) << s) << tsh];
        const float2 ws = TW[(((512 & (half - 1)) << s) << tsh) & 8191];
        for (int j = tid; j < N / 2; j += NTHREADS) {
            const int pos = j & (half - 1), i0 = ((j >> hb) << (hb + 1)) + pos, i1 = i0 + half;
            const float2 a = x[i0], bb = x[i1];
            const float dr = a.x - bb.x, di = a.y - bb.y;
            x[i0] = make_float2(a.x + bb.x, a.y + bb.y);
            x[i1] = make_float2(dr * w.x - di * w.y, dr * w.y + di * w.x);
            if (half > 512) { const float nx = w.x * ws.x - w.y * ws.y, ny = w.x * ws.y + w.y * ws.x; const bool wrap = ((j + NTHREADS) >> hb) != (j >> hb); w.x = wrap ? -nx : nx; w.y = wrap ? -ny : ny; }
        }
        __syncthreads();
    }
    const float scale = LOGN == 14 ? (1.f / 128.f) : (1.f / 16.f);
    bf16_t* OT = (bf16_t*)(p->ws + WS_OT) + (size_t)(b * 4 + g) * 128 * NTOK + t0;
    bf16_t* o1 = OT + (size_t)(m == 0 ? 0 : m) * NTOK; bf16_t* o2 = OT + (size_t)(m == 0 ? 64 : 128 - m) * NTOK;
    for (int k = tid * 2; k < N; k += NTHREADS * 2) {
        float va[2], vb[2];
#pragma unroll
        for (int e = 0; e < 2; ++e) {
            const int kk = k + e, kr = (int)(__brev((unsigned)kk) >> (32 - LOGN)), k2 = (N - kk) & (N - 1), k2r = (int)(__brev((unsigned)k2) >> (32 - LOGN));
            const float2 z1 = x[kr], z2 = x[k2r];
            if (m == 0) { va[e] = 0.5f * (z1.x + z2.x) * scale; vb[e] = 0.5f * (z1.y + z2.y) * scale; }
            else { va[e] = z1.x * scale; vb[e] = z2.x * scale; }
        }
        *reinterpret_cast<unsigned*>(o1 + k) = cvtpk(va[0], va[1]); *reinterpret_cast<unsigned*>(o2 + k) = cvtpk(vb[0], vb[1]);
    }
    __syncthreads();
}
__device__ __forceinline__ float2 cmulf(float2 a, float2 b) { return make_float2(a.x * b.x - a.y * b.y, a.x * b.y + a.y * b.x); }
__device__ __forceinline__ void fft16k_unit(CP p, int b, int g, int m, char* lds) {
    constexpr float CR[16] = {1.000000000e+00f, 9.807852804e-01f, 9.238795325e-01f, 8.314696123e-01f, 7.071067812e-01f, 5.555702330e-01f, 3.826834324e-01f, 1.950903220e-01f, 6.123233996e-17f, -1.950903220e-01f, -3.826834324e-01f, -5.555702330e-01f, -7.071067812e-01f, -8.314696123e-01f, -9.238795325e-01f, -9.807852804e-01f};
    constexpr float CI[16] = {-0.000000000e+00f, -1.950903220e-01f, -3.826834324e-01f, -5.555702330e-01f, -7.071067812e-01f, -8.314696123e-01f, -9.238795325e-01f, -9.807852804e-01f, -1.000000000e+00f, -9.807852804e-01f, -9.238795325e-01f, -8.314696123e-01f, -7.071067812e-01f, -5.555702330e-01f, -3.826834324e-01f, -1.950903220e-01f};
    const int tid = otid(), N = 16384, LOGN = 14, t0 = CTX;
    float2* x = (float2*)lds;
    const float2* TW = (const float2*)(p->ws + WS_TW);
    float2 v[32];
    { const unsigned* GT = (const unsigned*)(p->ws + WS_GT) + ((size_t)(b * 4 + g) * 64 + m) * NTOK + t0;
#pragma unroll
      for (int i = 0; i < 32; ++i) { const unsigned w = GT[(i << 9) | tid]; v[i] = make_float2(bflo(w), bfhi(w)); } }
#pragma unroll
    for (int s = 0; s < 5; ++s) { const int ib = 4 - s; const float2 base = TW[tid << s];
#pragma unroll
        for (int i0 = 0; i0 < 32; ++i0) if (!((i0 >> ib) & 1)) { const int i1 = i0 | (1 << ib), mm = (i0 & ((1 << ib) - 1)) << s;
            const float2 tw = cmulf(base, make_float2(CR[mm], CI[mm])), a = v[i0], bb = v[i1];
            v[i0] = make_float2(a.x + bb.x, a.y + bb.y); v[i1] = cmulf(make_float2(a.x - bb.x, a.y - bb.y), tw); } }
#pragma unroll
    for (int i = 0; i < 32; ++i) { const int n = (i << 9) | tid; x[n + (n >> 4)] = v[i]; }
    __syncthreads();
    { const int hi9 = (tid >> 4) << 9, lo = tid & 15;
#pragma unroll
      for (int i = 0; i < 32; ++i) { const int n = hi9 | (i << 4) | lo; v[i] = x[n + (n >> 4)]; }
#pragma unroll
      for (int s = 5; s < 10; ++s) { const int ib = 9 - s; const float2 base = TW[lo << s];
#pragma unroll
          for (int i0 = 0; i0 < 32; ++i0) if (!((i0 >> ib) & 1)) { const int i1 = i0 | (1 << ib), mm = (i0 & ((1 << ib) - 1)) << (s - 5);
              const float2 tw = cmulf(base, make_float2(CR[mm], CI[mm])), a = v[i0], bb = v[i1];
              v[i0] = make_float2(a.x + bb.x, a.y + bb.y); v[i1] = cmulf(make_float2(a.x - bb.x, a.y - bb.y), tw); } }
#pragma unroll
      for (int i = 0; i < 32; ++i) { const int n = hi9 | (i << 4) | lo; x[n + (n >> 4)] = v[i]; } }
    __syncthreads();
#pragma unroll
    for (int i = 0; i < 32; ++i) { const int n = ((2 * tid + (i >> 4)) << 4) | (i & 15); v[i] = x[n + (n >> 4)]; }
#pragma unroll
    for (int s = 10; s < 14; ++s) { const int ib = 13 - s;
#pragma unroll
        for (int i0 = 0; i0 < 32; ++i0) if (!((i0 >> ib) & 1)) { const int i1 = i0 | (1 << ib), mm = ((i0 & 15) & ((1 << ib) - 1)) << (s - 9);
            const float2 a = v[i0], bb = v[i1];
            v[i0] = make_float2(a.x + bb.x, a.y + bb.y); v[i1] = cmulf(make_float2(a.x - bb.x, a.y - bb.y), make_float2(CR[mm], CI[mm])); } }
#pragma unroll
    for (int i = 0; i < 32; ++i) { const int n = ((2 * tid + (i >> 4)) << 4) | (i & 15); x[n + (n >> 4)] = v[i]; }
    __syncthreads();
    const float scale = 1.f / 128.f;
    bf16_t* OT = (bf16_t*)(p->ws + WS_OT) + (size_t)(b * 4 + g) * 128 * NTOK + t0;
    bf16_t* o1 = OT + (size_t)(m == 0 ? 0 : m) * NTOK; bf16_t* o2 = OT + (size_t)(m == 0 ? 64 : 128 - m) * NTOK;
    for (int k = tid * 2; k < N; k += NTHREADS * 2) {
        float va[2], vb[2];
#pragma unroll
        for (int e = 0; e < 2; ++e) {
            const int kk = k + e, kr = (int)(__brev((unsigned)kk) >> (32 - LOGN)), k2 = (N - kk) & (N - 1), k2r = (int)(__brev((unsigned)k2) >> (32 - LOGN));
            const float2 z1 = x[kr + (kr >> 4)], z2 = x[k2r + (k2r >> 4)];
            if (m == 0) { va[e] = 0.5f * (z1.x + z2.x) * scale; vb[e] = 0.5f * (z1.y + z2.y) * scale; }
            else { va[e] = z1.x * scale; vb[e] = z2.x * scale; }
        }
        *reinterpret_cast<unsigned*>(o1 + k) = cvtpk(va[0], va[1]); *reinterpret_cast<unsigned*>(o2 + k) = cvtpk(vb[0], vb[1]);
    }
    __syncthreads();
}
__device__ __forceinline__ void fnet_transpose_unit(CP p, int b, int g, int tb, char* lds) {
    const int tid = otid();
    bf16_t* tile = (bf16_t*)lds;
    const bf16_t* OT = (const bf16_t*)(p->ws + WS_OT) + (size_t)(b * 4 + g) * 128 * NTOK + tb * 64;
    { const int c = tid >> 2, q = tid & 3;
      const u32x4 v0 = *reinterpret_cast<const u32x4*>(OT + (size_t)c * NTOK + q * 16), v1 = *reinterpret_cast<const u32x4*>(OT + (size_t)c * NTOK + q * 16 + 8);
#pragma unroll
      for (int e = 0; e < 4; ++e) { tile[(q * 16 + 2 * e) * 136 + c] = (bf16_t)(v0[e] & 0xffffu); tile[(q * 16 + 2 * e + 1) * 136 + c] = (bf16_t)(v0[e] >> 16);
                                    tile[(q * 16 + 8 + 2 * e) * 136 + c] = (bf16_t)(v1[e] & 0xffffu); tile[(q * 16 + 8 + 2 * e + 1) * 136 + c] = (bf16_t)(v1[e] >> 16); } }
    __syncthreads();
    { const int t = tid >> 3, cq = tid & 7;
      const u32x4 v0 = *reinterpret_cast<const u32x4*>(tile + t * 136 + cq * 16), v1 = *reinterpret_cast<const u32x4*>(tile + t * 136 + cq * 16 + 8);
      unsigned char* dst = (unsigned char*)(p->ws + WS_MIX) + (size_t)(b * NTOK + tb * 64 + t) * DM + 1536 + g * 128 + cq * 16;
      u32x4 w;
#pragma unroll
      for (int e = 0; e < 2; ++e) { w[e] = f2f8x4(0.25f * bflo(v0[2 * e]), 0.25f * bfhi(v0[2 * e]), 0.25f * bflo(v0[2 * e + 1]), 0.25f * bfhi(v0[2 * e + 1]));
                                    w[2 + e] = f2f8x4(0.25f * bflo(v1[2 * e]), 0.25f * bfhi(v1[2 * e]), 0.25f * bflo(v1[2 * e + 1]), 0.25f * bfhi(v1[2 * e + 1])); }
      *reinterpret_cast<u32x4*>(dst) = w; }
    __syncthreads();
}

#define EPI_LOOP for (int ai = 0; ai < 2; ++ai) for (int m = 0; m < 4; ++m) for (int bj = 0; bj < 2; ++bj) for (int n = 0; n < 2; ++n)
struct EpiBf16 {
    bf16_t* O; int ldc, brow, bcol, ncols;
    __device__ __forceinline__ void operator()(const f32x4 (&acc)[2][2][4][2], int wr, int wc, int fr, int fq) const {
#pragma unroll
        EPI_LOOP { const int row = brow + ai * 128 + wr * 64 + m * 16 + fr, col = bcol + bj * 128 + wc * 32 + n * 16 + fq * 4;
            if (col < ncols) { const f32x4 v = acc[ai][bj][m][n]; u32x2 w = {cvtpk(v[0], v[1]), cvtpk(v[2], v[3])}; *reinterpret_cast<u32x2*>(O + (size_t)row * ldc + col) = w; } }
    }
};
struct EpiIn {
    bf16_t* PL; unsigned* GT; unsigned char* VTG; int brow, bcol;
    __device__ __forceinline__ void operator()(const f32x4 (&acc)[2][2][4][2], int wr, int wc, int fr, int fq) const {
        const int b = brow / NTOK, t0 = brow - b * NTOK, r0 = wr * 64 + fr;
#pragma unroll
        for (int bj = 0; bj < 2; ++bj) {
            const int colu = __builtin_amdgcn_readfirstlane(bcol + bj * 128 + wc * 32), col = colu + fq * 4;
            if (colu < OFF_D) {
                bf16_t* base = PL + (size_t)brow * INC; const unsigned o0 = (unsigned)(r0 * INC + col);
                if (!(colu >= OFF_B + 768 && colu < OFF_C))
#pragma unroll
                for (int ai = 0; ai < 2; ++ai)
#pragma unroll
                    for (int m = 0; m < 4; ++m)
#pragma unroll
                        for (int n = 0; n < 2; ++n) { const f32x4 v = acc[ai][bj][m][n] * (1.f / 64.f); u32x2 w = {cvtpk(v[0], v[1]), cvtpk(v[2], v[3])};
                            *reinterpret_cast<u32x2*>(base + o0 + (unsigned)((ai * 128 + m * 16) * INC + n * 16)) = w; }
                if (colu >= OFF_B + 768 && colu < OFF_C) {
                    const int cv = col - (OFF_B + 768);
                    unsigned char* vb = VTG + ((size_t)(b * 2 + (cv >> 7)) * NCHUNK + (t0 >> 6) + wr) * 8192 + (cv & 127) * 64 + vt_pos(fr);
#pragma unroll
                    for (int n = 0; n < 2; ++n)
#pragma unroll
                        for (int ai = 0; ai < 2; ++ai)
#pragma unroll
                            for (int m = 0; m < 4; ++m) { const f32x4 v = acc[ai][bj][m][n] * (1.f / 64.f);
#pragma unroll
                                for (int e = 0; e < 4; ++e) vb[ai * 2 * 8192 + n * 16 * 64 + 16 * (m >> 1) + 8 * (m & 1) + e * 64] = f2f8(v[e]); }
                }
            } else if (colu < INC) {
#pragma unroll
                for (int n = 0; n < 2; ++n) {
                    const int d = col + n * 16 - OFF_D, g = d >> 7, mm = (d & 127) >> 1; unsigned* dst = GT + ((size_t)(b * 4 + g) * 64 + mm) * NTOK + t0 + r0;
#pragma unroll
                    for (int ai = 0; ai < 2; ++ai)
#pragma unroll
                        for (int m = 0; m < 4; ++m) { const f32x4 v = acc[ai][bj][m][n] * (1.f / 64.f); dst[ai * 128 + m * 16] = cvtpk(v[0], v[1]); dst[NTOK + ai * 128 + m * 16] = cvtpk(v[2], v[3]); }
                }
            }
        }
    }
};
struct EpiKV {
    unsigned char* K8M; unsigned char* VTM; int brow, head;
    __device__ __forceinline__ void operator()(const f32x4 (&acc)[2][2][4][2], int wr, int wc, int fr, int fq) const {
        const int b = brow / NTOK, t0 = brow - b * NTOK;
#pragma unroll
        EPI_LOOP { const int rl = ai * 128 + wr * 64 + m * 16 + fr, c = wc * 32 + n * 16 + fq * 4;
            const f32x4 v = acc[ai][bj][m][n];
            if (bj == 0) *reinterpret_cast<unsigned*>(K8M + (size_t)(brow + rl) * 768 + head * 192 + c) = f2f8x4(v[0], v[1], v[2], v[3]);
            else { const int t = t0 + rl; unsigned char* dst = VTM + ((size_t)(b * 4 + head) * NCHUNK + (t >> 6)) * 8192 + c * 64 + vt_pos(t & 63);
#pragma unroll
                for (int e = 0; e < 4; ++e) dst[e * 64] = f2f8(v[e]); } }
    }
};
struct EpiGlu {
    unsigned char* MIX; int brow, pn;
    __device__ __forceinline__ void operator()(const f32x4 (&acc)[2][2][4][2], int wr, int wc, int fr, int fq) const {
#pragma unroll
        for (int ai = 0; ai < 2; ++ai) for (int m = 0; m < 4; ++m) for (int n = 0; n < 2; ++n) {
            const int row = brow + ai * 128 + wr * 64 + m * 16 + fr, c = wc * 32 + n * 16 + fq * 4;
            const f32x4 a = acc[ai][0][m][n], b = acc[ai][1][m][n]; f32x4 v;
#pragma unroll
            for (int j = 0; j < 4; ++j) v[j] = a[j] * sigmoid_hw(b[j]);
            *reinterpret_cast<unsigned*>(MIX + (size_t)row * DM + 1024 + pn * 128 + c) = f2f8x4(v[0], v[1], v[2], v[3]); __builtin_amdgcn_sched_barrier(0); }
    }
};
struct EpiRes {
    CP p; int l, brow, bcol;
    __device__ __forceinline__ void operator()(const f32x4 (&acc)[2][2][4][2], int wr, int wc, int fr, int fq) const {
        int br = brow; asm volatile("" : "+s"(br));
        const float* src0 = xin_row(p, br); bf16_t* dst0 = xres_row(p, br);
        const int ldx = (br % NTOK) < CTX ? DM : 2 * DM;
        const float* g1 = mod_row(p, l, br) + 2 * 2048;
        const int r0 = wr * 64 + fr;
#pragma unroll
        for (int bj = 0; bj < 2; ++bj) {
            const int col = bcol + bj * 128 + wc * 32 + fq * 4;
            const f32x4 g0 = *reinterpret_cast<const f32x4*>(g1 + col) * (1.f / 512.f), g16 = *reinterpret_cast<const f32x4*>(g1 + col + 16) * (1.f / 512.f);
            const unsigned os = (unsigned)(r0 * DM + col), od = (unsigned)(r0 * ldx + col);
#pragma unroll
            for (int ai = 0; ai < 2; ++ai) {
                f32x4 xv[4][2];
                if (l == 0) {
#pragma unroll
                    for (int m = 0; m < 4; ++m)
#pragma unroll
                        for (int n = 0; n < 2; ++n) xv[m][n] = *reinterpret_cast<const f32x4*>(src0 + os + (unsigned)((ai * 128 + m * 16) * DM + n * 16));
                } else {
#pragma unroll
                    for (int m = 0; m < 4; ++m)
#pragma unroll
                        for (int n = 0; n < 2; ++n) { const u32x2 w = *reinterpret_cast<const u32x2*>(dst0 + od + (unsigned)((ai * 128 + m * 16) * ldx + n * 16));
                            xv[m][n] = (f32x4){bflo(w[0]), bfhi(w[0]), bflo(w[1]), bfhi(w[1])}; }
                }
#pragma unroll
                for (int m = 0; m < 4; ++m)
#pragma unroll
                    for (int n = 0; n < 2; ++n) { const f32x4 v = xv[m][n] + (n == 0 ? g0 : g16) * acc[ai][bj][m][n]; u32x2 wo = {cvtpk(v[0], v[1]), cvtpk(v[2], v[3])};
                        *reinterpret_cast<u32x2*>(dst0 + od + (unsigned)((ai * 128 + m * 16) * ldx + n * 16)) = wo; }
            }
        }
    }
};
struct EpiMoe1 {
    unsigned char* ACT; int arow0, pn;
    __device__ __forceinline__ void operator()(const f32x4 (&acc)[2][2][4][2], int wr, int wc, int fr, int fq) const {
#pragma unroll
        for (int ai = 0; ai < 2; ++ai) for (int m = 0; m < 4; ++m) for (int n = 0; n < 2; ++n) {
            const int row = arow0 + ai * 128 + wr * 64 + m * 16 + fr, c = wc * 32 + n * 16 + fq * 4;
            const f32x4 a = acc[ai][0][m][n] * (1.f / 64.f), b = acc[ai][1][m][n] * (4.f / 64.f); f32x4 v;
#pragma unroll
            for (int j = 0; j < 4; ++j) v[j] = silu_hw(a[j]) * b[j];
            *reinterpret_cast<unsigned*>(ACT + (size_t)row * 1024 + pn * 128 + c) = f2f8x4(v[0], v[1], v[2], v[3]); __builtin_amdgcn_sched_barrier(0); }
    }
};
struct EpiMoe2 {
    unsigned char* Y; const int* list; int nvalid, bcol;
    __device__ __forceinline__ void operator()(const f32x4 (&acc)[2][2][4][2], int wr, int wc, int fr, int fq) const {
#pragma unroll
        for (int ai = 0; ai < 2; ++ai) for (int m = 0; m < 4; ++m) {
            const int r = ai * 128 + wr * 64 + m * 16 + fr;
            if (r < nvalid) { const int ent = list[r]; unsigned char* dst = Y + (size_t)ent * DM + bcol;
#pragma unroll
                for (int bj = 0; bj < 2; ++bj) for (int n = 0; n < 2; ++n) {
                    const f32x4 v = acc[ai][bj][m][n] * (16.f / 128.f);
                    *reinterpret_cast<unsigned*>(dst + bj * 128 + wc * 32 + n * 16 + fq * 4) = f2f8x4(v[0], v[1], v[2], v[3]); } }
        }
    }
};

__device__ __forceinline__ void aoff_rows(int (&aoff)[2][2], int brow, int lda, int R0, int C0) {
#pragma unroll
    for (int h = 0; h < 2; ++h)
#pragma unroll
        for (int i = 0; i < 2; ++i) aoff[h][i] = (brow + h * 128 + i * 64 + R0) * lda + C0;
}

template <int WGM>
__device__ __forceinline__ bool xcd_tile(int k, int nM, int nN, int& pm, int& pn) {
    const int bid = obid(), G = gridDim.x;
    const int v = (G & 7) == 0 ? ((k << 3) + (bid & 7)) * (G >> 3) + (bid >> 3) : k * G + bid;
    if (v >= nM * nN) return false;
    const int nig = WGM * nN, gid = v / nig, fm = gid * WGM, gsz = min(nM - fm, WGM), w = v - gid * nig;
    pn = w / gsz; pm = fm + (w - pn * gsz);
    return true;
}
__device__ __forceinline__ void phase_gemm_in(CP p, int l, char* lds) {
    const bf16_t* A = (const bf16_t*)(p->ws + WS_HL); const bf16_t* Bt = (const bf16_t*)(p->ws + WS_BTIN) + (size_t)l * INCP * 1024;
    for (int k = 0;; ++k) {
        int R0, C0; stage_coords(R0, C0);
        int pm, pn; if (!xcd_tile<8>(k, 130, 11, pm, pn)) break;
        int aoff[2][2]; aoff_rows(aoff, pm * 256, 1024, R0, C0);
        EpiIn e{(bf16_t*)(p->ws + WS_PL), (unsigned*)(p->ws + WS_GT), (unsigned char*)(p->ws + WS_VTG), pm * 256, pn * 256};
        gemm_unit<false, 1024, true, 0>(A, aoff, Bt, (pn * 256 + R0) * 1024 + C0, 1024, 1024, lds, e);
    }
}
__device__ __forceinline__ void phase_gemm_qkv_up(CP p, int l, char* lds) {
    const bf16_t* A2 = (const bf16_t*)(p->ws + WS_A2);
    for (int k = 0;; ++k) {
        int R0, C0; stage_coords(R0, C0);
        int pm, pn; if (!xcd_tile<8>(k, 130, 7, pm, pn)) break;
        int aoff[2][2];
        if (pn < 3) {
            aoff_rows(aoff, pm * 256, 640, R0, C0);
            EpiBf16 e{(bf16_t*)(p->ws + WS_QM), 768, pm * 256, pn * 256, 768};
            gemm_unit<false, 640, false, 0>(A2, aoff, (const bf16_t*)(p->ws + WS_BTUQ) + (size_t)l * 768 * 384, (pn * 256 + R0) * 384 + C0, 384, 384, lds, e);
        } else {
            aoff_rows(aoff, pm * 256, 640, R0, C0 + 384);
            EpiKV e{(unsigned char*)(p->ws + WS_K8M), (unsigned char*)(p->ws + WS_VTM), pm * 256, pn - 3};
            gemm_unit<false, 640, false, 0>(A2, aoff, (const bf16_t*)(p->ws + WS_BTUKV) + (size_t)l * 1024 * 256, ((pn - 3) * 256 + R0) * 256 + C0, 256, 256, lds, e);
        }
    }
}
__device__ __forceinline__ void phase_gemm_glu(CP p, int l, char* lds) {
    const bf16_t* A = (const bf16_t*)(p->ws + WS_YB); const bf16_t* Bt = (const bf16_t*)(p->ws + WS_BTGLU) + (size_t)l * 1024 * 512;
    for (int k = 0;; ++k) {
        int R0, C0; stage_coords(R0, C0);
        int pmi, pn; if (!xcd_tile<8>(k, l == 0 ? 130 : 128, 4, pmi, pn)) break;
        const int pm = l == 0 ? pmi : pmi + 1 + (pmi >= 64);
        int aoff[2][2]; aoff_rows(aoff, pm * 256, 512, R0, C0);
        EpiGlu e{(unsigned char*)(p->ws + WS_MIX), pm * 256, pn};
        gemm_unit<false, 512, false, 0>(A, aoff, Bt, (pn * 256 + R0) * 512 + C0, 512, 512, lds, e);
    }
}
__device__ __forceinline__ void phase_gemm_out(CP p, int l, char* lds) {
    const bf16_t* A = (const bf16_t*)(p->ws + WS_MIX); const bf16_t* Bt = (const bf16_t*)(p->ws + WS_BTOUT) + (size_t)l * 2048 * 1024;
    for (int k = 0;; ++k) {
        int R0, C0; stage_coords(R0, C0);
        int pmi, pn; if (!xcd_tile<8>(k, l == 0 ? 130 : 128, 8, pmi, pn)) break;
        const int pm = l == 0 ? pmi : pmi + 1 + (pmi >= 64);
        int aoff[2][2]; aoff_rows(aoff, pm * 256, 1024, R0, C0);
        EpiRes e{p, l, pm * 256, pn * 256};
        gemm_unit<false, 1024, true, 0>(A, aoff, Bt, (pn * 256 + R0) * 1024 + C0, 1024, 1024, lds, e);
    }
}
__device__ __forceinline__ bool moe_unit(const unsigned* CNT, int u, int ntn, int& e, int& mt, int& pn, int& tbase) {
    int tb = 0;
#pragma unroll 1
    for (int x = 0; x < 16; ++x) {
        const int nt_ = ((int)CNT[x * 16] + 255) >> 8;
        if (u < (tb + nt_) * ntn) { const int v = u - tb * ntn; e = x; mt = v / ntn; pn = v % ntn; tbase = tb; return true; }
        tb += nt_;
    }
    return false;
}
__device__ __forceinline__ int moe_tiles(const unsigned* CNT) {
    int t = 0;
#pragma unroll 1
    for (int x = 0; x < 16; ++x) t += ((int)CNT[x * 16] + 255) >> 8;
    return t;
}
__device__ __forceinline__ void phase_moe1(CP p, int l, char* lds) {
    const unsigned* CNT = (const unsigned*)(p->ws + WS_CTL) + CW_CNT + l * 16 * 16;
    const int* LIST = (const int*)(p->ws + WS_LIST); const bf16_t* A = (const bf16_t*)(p->ws + WS_HL);
    const int ntiles = moe_tiles(CNT);
    for (int k = 0;; ++k) {
        int R0, C0; stage_coords(R0, C0);
        int gt, gn; if (!xcd_tile<8>(k, ntiles, 8, gt, gn)) break;
        int e, mt, pn, tb; if (!moe_unit(CNT, gt * 8 + gn, 8, e, mt, pn, tb)) break;
        const int cnt = (int)CNT[e * 16]; const int* lst = LIST + (size_t)e * MR + mt * 256;
        int aoff[2][2];
#pragma unroll
        for (int h = 0; h < 2; ++h)
#pragma unroll
            for (int i = 0; i < 2; ++i) { const int r = h * 128 + i * 64 + R0; const int ent = (mt * 256 + r < cnt) ? lst[r] : lst[0]; aoff[h][i] = (ent >> 1) * 1024 + C0; }
        EpiMoe1 ep{(unsigned char*)(p->ws + WS_ACT), (tb + mt) * 256, pn};
        gemm_unit<true, 1024, true, 0>(A, aoff, (const bf16_t*)(p->ws + WS_BTGU) + (size_t)(l * 16 + e) * 2048 * 1024, (pn * 256 + R0) * 1024 + C0, 1024, 1024, lds, ep);
    }
}
__device__ __forceinline__ void phase_moe2(CP p, int l, char* lds) {
    const unsigned* CNT = (const unsigned*)(p->ws + WS_CTL) + CW_CNT + l * 16 * 16;
    const int* LIST = (const int*)(p->ws + WS_LIST); const bf16_t* A = (const bf16_t*)(p->ws + WS_ACT);
    const int ntiles = moe_tiles(CNT);
    for (int k = 0;; ++k) {
        int R0, C0; stage_coords(R0, C0);
        int gt, gn; if (!xcd_tile<8>(k, ntiles, 8, gt, gn)) break;
        int e, mt, pn, tb; if (!moe_unit(CNT, gt * 8 + gn, 8, e, mt, pn, tb)) break;
        const int cnt = (int)CNT[e * 16];
        int aoff[2][2]; aoff_rows(aoff, (tb + mt) * 256, 512, R0, C0);
        EpiMoe2 ep{(unsigned char*)(p->ws + WS_Y), LIST + (size_t)e * MR + mt * 256, cnt - mt * 256, pn * 256};
        gemm_unit<false, 512, true, 0>(A, aoff, (const bf16_t*)(p->ws + WS_BTDN) + (size_t)(l * 16 + e) * 2048 * 512, (pn * 256 + R0) * 512 + C0, 512, 512, lds, ep);
    }
}

__device__ __forceinline__ void attn_mla(CP p, int b, int h, int qb, char* lds) {
    const bf16_t* QM = (const bf16_t*)(p->ws + WS_QM); unsigned char* MIX = (unsigned char*)(p->ws + WS_MIX);
    const size_t r0 = (size_t)b * NTOK, rq = r0 + (size_t)qb * 256;
    attn_unit_f8<192, true, 768, 768, DM>(QM + rq * 768 + h * 192, (const unsigned char*)(p->ws + WS_K8M) + r0 * 768 + h * 192,
                         (const unsigned char*)(p->ws + WS_VTM) + (size_t)(b * 4 + h) * NCHUNK * 8192, MIX + rq * DM + h * 128, qb == 0 ? CTX : NTOK, (qb - 1) * 256, qb > 0, lds);
}
__device__ __forceinline__ void attn_gqa(CP p, int b, int h, int qb, char* lds) {
    const bf16_t* PL = (const bf16_t*)(p->ws + WS_PL); unsigned char* MIX = (unsigned char*)(p->ws + WS_MIX);
    const size_t r0 = (size_t)b * NTOK, rq = r0 + (size_t)qb * 256; const int kvh = h >> 1;
    attn_unit_f8<128, false, INC, 256, DM>(PL + rq * INC + OFF_B + h * 128, (const unsigned char*)(p->ws + WS_K8G) + r0 * 256 + kvh * 128,
                          (const unsigned char*)(p->ws + WS_VTG) + (size_t)(b * 2 + kvh) * NCHUNK * 8192, MIX + rq * DM + 512 + h * 128, qb == 0 ? CTX : NTOK, 0, false, lds);
}

__device__ __forceinline__ int attn_xcd_order(int u, int G) {
    if (G != 256 || u >= 512) return u;
    const int x = u & 7, j = (u >> 3) & 31;
    return (u & 256) | ((x >> 1) << 6) | ((x & 1) << 5) | j;
}
#ifndef PH_ONLY
#define PH_ONLY -1
#endif
__device__ __forceinline__ CP kparams() { CP kp = (CP)__builtin_amdgcn_kernarg_segment_ptr(); asm volatile("" : "+s"(kp)); return kp; }
#define PHASE(k) ((PH_ONLY < 0 || PH_ONLY == ((k) == 0 ? 0 : (k) == 21 ? 21 : 1 + ((k) - 1) % 10)) && p.ph_lo <= (k) && (k) < p.ph_hi)
#define SEAM(k) do { if (p.ph_lo <= (k) && (k) + 1 < p.ph_hi) xcd_barrier(bar); } while (0)

__global__ void __launch_bounds__(NTHREADS, 2) dit_fwd(Params p) {
    extern __shared__ __attribute__((aligned(16))) char lds[];
    uint4* xbw = (uint4*)(lds + LDS_BYTES - 16);
    if (threadIdx.x == 0) *xbw = make_uint4(0u, 0u, 0u, 0u);
    __syncthreads();
    XcdBarrier bar = xcd_barrier_post((unsigned*)(p.ws + WS_CTL), (volatile LAS unsigned*)xbw);
    const int G = gridDim.x;

    if (PHASE(0)) { const CP q = kparams(); prologue(q, lds); }
    SEAM(0);
#pragma unroll 1
    for (int l = 0; l < 2; ++l) {
        const int pb = 1 + 10 * l;
        if (PHASE(pb + 0)) { const CP q = kparams(); phase_norm1(q, l); }
        SEAM(pb + 0);
        if (PHASE(pb + 1)) { const CP q = kparams(); phase_gemm_in(q, l, lds); }
        SEAM(pb + 1);
        if (PHASE(pb + 2)) {
            if (p.sub & 1) { const CP q = kparams(); phase_post(q, l); }
            const int sub_ = p.sub, bid = obid();
            const CP p = kparams();
            if (sub_ & 2)
            phase_s5a_direct(p, l);
            if (sub_ & 4)
            for (int u = bid; u < 512; u += G) { const int b = u >> 8, g = (u >> 6) & 3, m = u & 63; fft16k_unit(p, b, g, m, lds); }
            if (l == 0 && (sub_ & 4)) for (int u = bid; u < 512; u += G) { const int b = u >> 8, g = (u >> 6) & 3, m = u & 63; fft_unit(p, b, 0, 8, g, m, lds); }
        }
        SEAM(pb + 2);
        if (PHASE(pb + 3)) {
            const int sub_ = p.sub, bid = obid();
            const CP p = kparams();
            if (sub_ & 1) for (int u = bid; u < 128; u += G) s5_carry_unit(p, l, u, lds);
            if (sub_ & 2) phase_gemm_qkv_up(p, l, lds);
            if (sub_ & 4) for (int u = bid; u < 2080; u += G) { const int tb = u % 260, g = (u / 260) & 3, b = u / 1040; if (l == 1 && tb < 4) continue; fnet_transpose_unit(p, b, g, tb, lds); }
        }
        SEAM(pb + 3);
        if (PHASE(pb + 4)) {
            const int sub_ = p.sub, bid = obid();
            const CP p = kparams();
            if (sub_ & 1) for (int u0 = bid; u0 < (l == 0 ? 520 : 512); u0 += G) { const int u = attn_xcd_order(u0, G); const int b = (u >> 8) & 1, h = (u >> 6) & 3, qb = u < 512 ? 1 + (u & 63) : 0; attn_mla(p, u < 512 ? b : ((u - 512) >> 2), u < 512 ? h : (u & 3), qb, lds); }
            if (sub_ & 2) for (int u0 = bid; u0 < (l == 0 ? 520 : 512); u0 += G) { const int u = attn_xcd_order(u0, G); const int b = (u >> 8) & 1, h = (u >> 6) & 3, qb = u < 512 ? 1 + (u & 63) : 0; attn_gqa(p, u < 512 ? b : ((u - 512) >> 2), u < 512 ? h : (u & 3), qb, lds); }
            if (sub_ & 4) phase_s5<1>(p, l, lds);
        }
        SEAM(pb + 4);
        if (PHASE(pb + 5)) { const CP q = kparams(); phase_gemm_glu(q, l, lds); }
        SEAM(pb + 5);
        if (PHASE(pb + 6)) { const CP q = kparams(); phase_gemm_out(q, l, lds); }
        SEAM(pb + 6);
        if (PHASE(pb + 7)) { const CP q = kparams(); phase_norm2(q, l, lds); }
        SEAM(pb + 7);
        if (PHASE(pb + 8)) { const CP q = kparams(); phase_moe1(q, l, lds); }
        SEAM(pb + 8);
        if (PHASE(pb + 9)) { const CP q = kparams(); phase_moe2(q, l, lds); }
        SEAM(pb + 9);
    }
    if (PHASE(21)) { const CP q = kparams(); phase_final(q); }
}

extern "C" void kernel_launch(void* const* d_in, const int* in_sizes, int n_in, void* d_out, int out_size, void* d_ws, size_t ws_size, hipStream_t stream) {
    static int grid = 0;
    if (grid == 0) {
        if (n_in != 31 || in_sizes[0] != NBATCH * SEQ * DM || out_size != NBATCH * SEQ * DM || ws_size < WS_END) {
            fprintf(stderr, "kernel_launch: shape mismatch (n_in %d, in0 %d, out %d, ws %zu, need %zu)\n", n_in, n_in > 0 ? in_sizes[0] : -1, out_size, ws_size, (size_t)WS_END); grid = -1; return; }
        int dev = 0, cus = 0, per_cu = 0;
        if (hipGetDevice(&dev) != hipSuccess || hipDeviceGetAttribute(&cus, hipDeviceAttributeMultiprocessorCount, dev) != hipSuccess) { grid = -1; return; }
        if (hipFuncSetAttribute((const void*)dit_fwd, hipFuncAttributeMaxDynamicSharedMemorySize, LDS_BYTES) != hipSuccess) { fprintf(stderr, "kernel_launch: hipFuncSetAttribute failed\n"); grid = -1; return; }
        if (hipOccupancyMaxActiveBlocksPerMultiprocessor(&per_cu, (const void*)dit_fwd, NTHREADS, LDS_BYTES) != hipSuccess || per_cu < 1)
            fprintf(stderr, "kernel_launch: occupancy query reports %d workgroups per CU\n", per_cu);
        (void)hipGetLastError();
        grid = cus;
    }
    if (grid < 0) return;
    (void)hipMemsetAsync((char*)d_ws + WS_CTL, 0, CTL_BYTES, stream);
    Params p{};
    for (int i = 0; i < 31; ++i) p.in[i] = (const float*)d_in[i];
    p.out = (float*)d_out; p.ws = (unsigned char*)d_ws;
#if MK_MULTI
    p.sub = -1;
    for (int k = 0; k < 22; ++k) { if (DBG_STOP && k >= DBG_STOP && k != 21) continue; p.ph_lo = k; p.ph_hi = k + 1; hipLaunchKernelGGL(dit_fwd, dim3(grid), dim3(NTHREADS), LDS_BYTES, stream, p); }
#else
    p.sub = -1;
#if PROBE_DRY
    p.dry = 0; p.ph_lo = 0; p.ph_hi = PROBE_PHASE; hipLaunchKernelGGL(dit_fwd, dim3(grid), dim3(NTHREADS), LDS_BYTES, stream, p);
    (void)hipMemsetAsync((char*)d_ws + WS_CTL, 0, 16384, stream);
    p.dry = 1; p.ph_lo = PROBE_PHASE; p.ph_hi = PROBE_PHASE + 1; p.sub = PROBE_SUB; hipLaunchKernelGGL(dit_fwd, dim3(grid), dim3(NTHREADS), LDS_BYTES, stream, p);
    (void)hipMemsetAsync((char*)d_ws + WS_CTL, 0, 16384, stream);
    p.dry = 0; p.sub = -1; p.ph_lo = PROBE_PHASE; p.ph_hi = 22; hipLaunchKernelGGL(dit_fwd, dim3(grid), dim3(NTHREADS), LDS_BYTES, stream, p);
#elif PROBE_PHASE >= 0
    p.ph_lo = 0; p.ph_hi = PROBE_PHASE + 1; hipLaunchKernelGGL(dit_fwd, dim3(grid), dim3(NTHREADS), LDS_BYTES, stream, p);
    (void)hipMemsetAsync((char*)d_ws + WS_CTL, 0, 16384, stream);
    p.ph_lo = PROBE_PHASE; p.ph_hi = PROBE_PHASE + 1; p.sub = PROBE_SUB; hipLaunchKernelGGL(dit_fwd, dim3(grid), dim3(NTHREADS), LDS_BYTES, stream, p);
    (void)hipMemsetAsync((char*)d_ws + WS_CTL, 0, 16384, stream);
    p.sub = -1; p.ph_lo = PROBE_PHASE + 1; p.ph_hi = 22; if (PROBE_PHASE < 21) hipLaunchKernelGGL(dit_fwd, dim3(grid), dim3(NTHREADS), LDS_BYTES, stream, p);
#else
    p.ph_lo = 0; p.ph_hi = 22;
    hipLaunchKernelGGL(dit_fwd, dim3(grid), dim3(NTHREADS), LDS_BYTES, stream, p);
#endif
#endif
    const hipError_t le = hipPeekAtLastError();
    if (le != hipSuccess) fprintf(stderr, "kernel_launch: launch failed: %s\n", hipGetErrorName(le));
}
```

```cpp
#include <hip/hip_runtime.h>
#include <cstdio>
#include <cstdint>

#ifndef MK_MULTI
#define MK_MULTI 0
#endif
#ifndef DBG_STOP
#define DBG_STOP 0
#endif
#ifndef DBG_TAP
#define DBG_TAP 0
#endif
#ifndef GEMM_OLDOFF
#define GEMM_OLDOFF 1
#endif
#ifndef DBG_SKIP
#define DBG_SKIP 0
#endif
#ifndef PROBE_PHASE
#define PROBE_PHASE -1
#endif
#ifndef PROBE_SUB
#define PROBE_SUB -1
#endif
#ifndef PROBE_DRY
#define PROBE_DRY 0
#endif
#ifndef DBG_REP
#define DBG_REP 0
#endif

typedef unsigned short bf16_t;
typedef short bf16x8 __attribute__((ext_vector_type(8)));
typedef short s16x4 __attribute__((ext_vector_type(4)));
typedef float f32x4 __attribute__((ext_vector_type(4)));
typedef float f32x16 __attribute__((ext_vector_type(16)));
typedef unsigned u32x4 __attribute__((ext_vector_type(4)));
typedef unsigned u32x2 __attribute__((ext_vector_type(2)));

constexpr int DM = 2048, NBATCH = 2, SEQ = 16384, CTX = 256, NTOK = SEQ + CTX, MR = NBATCH * NTOK;
constexpr int INC = 2624, OFF_B = 576, OFF_C = 1600, OFF_D = 2112, INCP = 2816;
constexpr int NEXP = 16, DEXP = 1024;
constexpr int NCHUNK = NTOK / 64;
constexpr float RMS_EPS = 1e-6f;
constexpr int NTHREADS = 512;
constexpr int LDS_BYTES = 147456;
constexpr int ACT_ROWS = 2 * MR + NEXP * 256;

constexpr size_t al256(size_t x) { return (x + 255) & ~size_t(255); }
constexpr size_t WS_CTL = 0, CTL_BYTES = 32768;
constexpr size_t WS_MOD = CTL_BYTES;
constexpr size_t WS_TW = WS_MOD + al256(2 * 3 * 12288 * 4);
constexpr size_t WS_S5LAM = WS_TW + 65536;
constexpr size_t WS_S5BM = WS_S5LAM + 2 * 2 * 32 * 64 * 16;
constexpr size_t WS_S5CM = WS_S5BM + 2 * 2 * 32 * 128 * 16 * 2;
constexpr size_t WS_BTIN = WS_S5CM + 2 * 32 * 16 * 256 * 2;
constexpr size_t WS_BTUQ = WS_BTIN + (size_t)2 * INCP * 2048 * 2;
constexpr size_t WS_BTUKV = WS_BTUQ + (size_t)2 * 768 * 384 * 2;
constexpr size_t WS_BTGLU = WS_BTUKV + (size_t)2 * 1024 * 256 * 2;
constexpr size_t WS_BTOUT = WS_BTGLU + (size_t)2 * 1024 * 512 * 2;
constexpr size_t WS_BTGU = WS_BTOUT + (size_t)2 * 2048 * 2048 * 2;
constexpr size_t WS_BTDN = WS_BTGU + (size_t)2 * 16 * 2048 * 2048 * 2;
constexpr size_t WS_HL = WS_BTDN + (size_t)2 * 16 * 2048 * 1024 * 2;
constexpr size_t WS_CTXX = WS_HL + (size_t)MR * 2048 * 2;
constexpr size_t WS_GATE = WS_CTXX + (size_t)512 * 2048 * 4;
constexpr size_t WS_LIST = WS_GATE + al256((size_t)MR * 2 * 4);
constexpr size_t WS_R = WS_LIST + al256((size_t)16 * MR * 4);
constexpr size_t WS_PL = WS_R;
constexpr size_t WS_A2 = WS_PL + (size_t)MR * INC * 2;
constexpr size_t WS_QM = WS_A2 + (size_t)MR * 640 * 2;
constexpr size_t WS_KM = WS_QM + (size_t)MR * 768 * 2;
constexpr size_t WS_VM = WS_KM + (size_t)MR * 768 * 2;
constexpr size_t WS_MIX = WS_VM + (size_t)MR * 512 * 2;
constexpr size_t WS_S5E = WS_MIX + (size_t)MR * 2048 * 2;
constexpr size_t WS_S5H = WS_S5E + (size_t)2 * 2 * 32 * NCHUNK * 128 * 4;
constexpr size_t WS_YB = WS_S5H + (size_t)2 * 2 * 32 * NCHUNK * 128 * 4;
constexpr size_t WS_GT = WS_YB + (size_t)MR * 512 * 2;
constexpr size_t WS_OT = WS_GT + (size_t)NBATCH * 4 * 64 * NTOK * 4;
constexpr size_t WS_K8M = WS_OT + (size_t)NBATCH * 4 * 128 * NTOK * 2;
constexpr size_t WS_VTM = WS_K8M + (size_t)MR * 768;
constexpr size_t WS_K8G = WS_VTM + (size_t)NBATCH * 4 * NCHUNK * 8192;
constexpr size_t WS_VTG = WS_K8G + (size_t)MR * 256;
constexpr size_t WS_END1 = WS_VTG + (size_t)NBATCH * 2 * NCHUNK * 8192;
constexpr size_t WS_ACT = WS_R;
constexpr size_t WS_Y = WS_ACT + al256((size_t)ACT_ROWS * 1024 * 2);
constexpr size_t WS_END2 = WS_Y + (size_t)MR * 2 * 2048 * 2;
constexpr size_t WS_END = WS_END1 > WS_END2 ? WS_END1 : WS_END2;
constexpr size_t WS_DRY = WS_END2;
static_assert(WS_DRY + (size_t)NTOK * 2048 * 4 <= WS_END1, "dry-run area");

constexpr int CW_CNT = 4096;

struct Params {
    const float* in[31];
    float* out;
    unsigned char* ws;
    int ph_lo, ph_hi;
    int sub, dry;
};
typedef const Params __attribute__((address_space(4)))* CP;

typedef float f32x2 __attribute__((ext_vector_type(2)));
typedef __bf16 bf16x2_t __attribute__((ext_vector_type(2)));
__device__ __forceinline__ unsigned cvtpk(float lo, float hi) { f32x2 f = {lo, hi}; bf16x2_t v = __builtin_convertvector(f, bf16x2_t); return __builtin_bit_cast(unsigned, v); }
__device__ __forceinline__ bf16_t f2bf(float x) { return (bf16_t)(cvtpk(x, x) & 0xffffu); }
typedef int i32x8 __attribute__((ext_vector_type(8)));
typedef int i32x4 __attribute__((ext_vector_type(4)));
__device__ __forceinline__ unsigned f2f8x4(float a, float b, float c, float d) { int w = __builtin_amdgcn_cvt_pk_fp8_f32(a, b, 0, false); return (unsigned)__builtin_amdgcn_cvt_pk_fp8_f32(c, d, w, true); }
__device__ __forceinline__ unsigned char f2f8(float a) { return (unsigned char)(__builtin_amdgcn_cvt_pk_fp8_f32(a, a, 0, false) & 0xff); }
__device__ __forceinline__ int vt_pos(int k) { const int blk = k >> 5, kk = k & 31; return 32 * ((kk >> 2) & 1) + 16 * blk + (kk & 3) + 4 * (kk >> 3); }
__device__ __forceinline__ float bf2f(bf16_t u) { return __uint_as_float(((unsigned)u) << 16); }
__device__ __forceinline__ float bflo(unsigned w) { return __uint_as_float(w << 16); }
__device__ __forceinline__ float bfhi(unsigned w) { return __uint_as_float(w & 0xffff0000u); }
template <int K> __device__ __forceinline__ float swz_xor(float v) { return __int_as_float(__builtin_amdgcn_ds_swizzle(__float_as_int(v), (K << 10) | 0x1f)); }
__device__ __forceinline__ float half_sum(float v) { auto r = __builtin_amdgcn_permlane32_swap(__float_as_uint(v), __float_as_uint(v), false, false); return __uint_as_float(r[0]) + __uint_as_float(r[1]); }
__device__ __forceinline__ float half_other(float v, bool lo) { auto r = __builtin_amdgcn_permlane32_swap(__float_as_uint(v), __float_as_uint(v), false, false); return __uint_as_float(lo ? r[1] : r[0]); }
__device__ __forceinline__ float wave_sum(float v) {
    v += swz_xor<16>(v); v += swz_xor<8>(v); v += swz_xor<4>(v); v += swz_xor<2>(v); v += swz_xor<1>(v);
    return half_sum(v);
}
__device__ __forceinline__ int otid() { int t = threadIdx.x; asm volatile("" : "+v"(t)); return t; }
__device__ __forceinline__ int obid() { int b = blockIdx.x; asm volatile("" : "+s"(b)); return b; }
__device__ __forceinline__ void st_wt(float* p, float v) { __hip_atomic_store(p, v, __ATOMIC_RELAXED, __HIP_MEMORY_SCOPE_AGENT); }
__device__ __forceinline__ void st_wt(int* p, int v) { __hip_atomic_store(p, v, __ATOMIC_RELAXED, __HIP_MEMORY_SCOPE_AGENT); }
__device__ __forceinline__ void st_wt(unsigned* p, unsigned v) { __hip_atomic_store(p, v, __ATOMIC_RELAXED, __HIP_MEMORY_SCOPE_AGENT); }
__device__ __forceinline__ float silu_f(float x) { return x / (1.f + expf(-x)); }
__device__ __forceinline__ float sigmoid_f(float x) { return 1.f / (1.f + expf(-x)); }
__device__ __forceinline__ float sigmoid_hw(float x) { return __builtin_amdgcn_rcpf(1.f + __builtin_amdgcn_exp2f(-1.4426950408889634f * x)); }
__device__ __forceinline__ float silu_hw(float x) { return x * sigmoid_hw(x); }

#define XB_TMO      128
#define XB_XCNT(j)  (256  + 64 * (j))
#define XB_XSUB(j)  (1280 + 64 * (j))
#define XB_XGEN(j)  (2304 + 64 * (j))
#define XB_TOP      3328
#define XB_TOPGEN   3392
#define XCD_BAR_WORDS 3456
#define XB_SPIN_CAP (1u << 18)
#define LAS __attribute__((address_space(3)))

__device__ __forceinline__ unsigned xb_ld(unsigned* p)              { return __hip_atomic_load(p, __ATOMIC_RELAXED, __HIP_MEMORY_SCOPE_AGENT); }
__device__ __forceinline__ unsigned xb_add(unsigned* p, unsigned v) { return __hip_atomic_fetch_add(p, v, __ATOMIC_RELAXED, __HIP_MEMORY_SCOPE_AGENT); }
__device__ __forceinline__ unsigned xb_xcc_id() { return (unsigned)__builtin_amdgcn_s_getreg((3 << 11) | 20) & 0xFu; }
#define XB_SPIN(cond, bar) do { unsigned _sp = 0; while (cond) { __builtin_amdgcn_s_sleep(1); \
    if ((++_sp & 255u) == 0u) { if (xb_ld(&(bar)[XB_TMO])) break; if (_sp > XB_SPIN_CAP) { atomicAdd(&(bar)[XB_TMO], 1u); break; } } } } while (0)

struct XcdBarrier { unsigned* bar; unsigned x; volatile LAS unsigned* st; };

__device__ __forceinline__ XcdBarrier xcd_barrier_post(unsigned* bar, volatile LAS unsigned* st) {
    XcdBarrier b; b.bar = bar; b.x = xb_xcc_id(); b.st = st;
    if (threadIdx.x == 0) (void)xb_add(&bar[XB_XCNT(b.x)], 1u);
    return b;
}
__device__ __forceinline__ void xcd_barrier_complete(unsigned* bar, unsigned x, unsigned& nloc, unsigned& nx) {
    const unsigned G = gridDim.x * gridDim.y * gridDim.z;
    unsigned sum, cnt, mine, sp = 0u;
    for (;;) {
        sum = 0u; cnt = 0u; mine = 0u;
#pragma unroll
        for (unsigned j = 0; j < 16; ++j) { const unsigned c = xb_ld(&bar[XB_XCNT(j)]); sum += c; cnt += (c > 0u) ? 1u : 0u; mine = (j == x) ? c : mine; }
        if (sum == G) break;
        __builtin_amdgcn_s_sleep(1);
        if ((++sp & 255u) == 0u) { if (xb_ld(&bar[XB_TMO])) break; if (sp > XB_SPIN_CAP) { atomicAdd(&bar[XB_TMO], 1u); break; } }
    }
    nloc = mine > 0u ? mine : 1u; nx = cnt > 0u ? cnt : 1u;
}
__device__ __noinline__ void xcd_barrier_impl(unsigned* bar_, unsigned x_, volatile LAS unsigned* st_) {
    XcdBarrier b; b.bar = bar_; b.x = x_; b.st = st_;
    asm volatile("s_waitcnt vmcnt(0)" ::: "memory");
    __syncthreads();
    if (threadIdx.x == 0) {
        unsigned* bar = b.bar;
        __builtin_amdgcn_s_waitcnt(0);
        unsigned nloc = b.st[0], nx = b.st[1];
        if (nloc == 0u) { xcd_barrier_complete(bar, b.x, nloc, nx); b.st[0] = nloc; b.st[1] = nx; }
        const unsigned old = xb_add(&bar[XB_XSUB(b.x)], 1u);
        const unsigned gen = old / nloc;
        if (old + 1u == (gen + 1u) * nloc) {
            __builtin_amdgcn_fence(__ATOMIC_RELEASE, "agent");
            asm volatile("s_waitcnt vmcnt(0)" ::: "memory");
            const unsigned og = xb_add(&bar[XB_TOP], 1u);
            const unsigned tg = og / nx;
            if (og + 1u == (tg + 1u) * nx) xb_add(&bar[XB_TOPGEN], 1u);
            else XB_SPIN(xb_ld(&bar[XB_TOPGEN]) == tg, bar);
            __builtin_amdgcn_fence(__ATOMIC_ACQUIRE, "agent");
            xb_add(&bar[XB_XGEN(b.x)], 1u);
            asm volatile("s_waitcnt vmcnt(0)" ::: "memory");
        } else {
            XB_SPIN(xb_ld(&bar[XB_XGEN(b.x)]) == gen, bar);
            __builtin_amdgcn_fence(__ATOMIC_ACQUIRE, "agent");
            asm volatile("s_waitcnt vmcnt(0)" ::: "memory");
        }
    }
    __syncthreads();
}
__device__ __forceinline__ void xcd_barrier(const XcdBarrier& b) { xcd_barrier_impl(b.bar, b.x, b.st); }

constexpr int G_BK = 64, G_HT = 128 * 64;
__device__ __forceinline__ int lds_byte(int r, int c) { int st = (r >> 4) * 2 + (c >> 5), rr = r & 15, cc = c & 31, ob = rr * 64 + cc * 2; return st * 1024 + (ob ^ (((ob >> 9) & 1) << 5)); }
__device__ __forceinline__ void stage_rc(int b, int& R, int& C) { int st = b / 1024, sb = b % 1024, swz = sb ^ (((sb >> 9) & 1) << 5); R = (st >> 1) * 16 + swz / 64; C = (st & 1) * 32 + (swz % 64) / 2; }

template <bool GATHER, int LDA, bool F8, int SCM, class Epi>
__device__ __forceinline__ void gemm_unit(const bf16_t* __restrict__ A, const int (&aoff)[2][2], const bf16_t* __restrict__ Bt, int boff0, int ldb, int K, char* lds, const Epi& epi) {
    bf16_t* shm = (bf16_t*)lds;
#define SA(b, h) (shm + ((b) * 2 + (h)) * G_HT)
#define SB(b, h) (shm + (4 + (b) * 2 + (h)) * G_HT)
#define STAGE_A(P, h, kt) do { \
    __builtin_amdgcn_global_load_lds((const unsigned*)(A + ((GATHER || GEMM_OLDOFF) ? (long)aoff[h][0] : (long)aoff[0][0] + (long)((h) * 128) * LDA) + (long)(kt) * G_BK), (unsigned*)((char*)(P) + tz * 16), 16, 0, 0); \
    __builtin_amdgcn_global_load_lds((const unsigned*)(A + ((GATHER || GEMM_OLDOFF) ? (long)aoff[h][1] : (long)aoff[0][0] + (long)((h) * 128 + 64) * LDA) + (long)(kt) * G_BK), (unsigned*)((char*)(P) + tz * 16 + 8192), 16, 0, 0); } while (0)
#define STAGE_B(P, h, kt) do { \
    __builtin_amdgcn_global_load_lds((const unsigned*)(Bt + (long)boff0 + (long)((h) * 128) * ldb + (long)(kt) * G_BK), (unsigned*)((char*)(P) + tz * 16), 16, 0, 0); \
    __builtin_amdgcn_global_load_lds((const unsigned*)(Bt + (long)boff0 + (long)((h) * 128 + 64) * ldb + (long)(kt) * G_BK), (unsigned*)((char*)(P) + tz * 16 + 8192), 16, 0, 0); } while (0)
#define LDA(dst, b, h) do { if constexpr (F8) { _Pragma("unroll") for (int m = 0; m < 4; ++m) { \
      const i32x4 lo_ = *reinterpret_cast<const i32x4*>((char*)SA(b, h) + lds_byte(wr * 64 + m * 16 + fr, fq * 8)), hi_ = *reinterpret_cast<const i32x4*>((char*)SA(b, h) + lds_byte(wr * 64 + m * 16 + fr, 32 + fq * 8)); \
      dst##8[m] = __builtin_shufflevector(lo_, hi_, 0, 1, 2, 3, 4, 5, 6, 7); } } \
    else { _Pragma("unroll") for (int m = 0; m < 4; ++m) _Pragma("unroll") for (int k = 0; k < 2; ++k) \
      dst[m][k] = *reinterpret_cast<const bf16x8*>((char*)SA(b, h) + lds_byte(wr * 64 + m * 16 + fr, k * 32 + fq * 8)); } } while (0)
#define LDB(dst, b, h) do { if constexpr (F8) { _Pragma("unroll") for (int n = 0; n < 2; ++n) { \
      const i32x4 lo_ = *reinterpret_cast<const i32x4*>((char*)SB(b, h) + lds_byte(wc * 32 + n * 16 + fr, fq * 8)), hi_ = *reinterpret_cast<const i32x4*>((char*)SB(b, h) + lds_byte(wc * 32 + n * 16 + fr, 32 + fq * 8)); \
      dst##8[n] = __builtin_shufflevector(lo_, hi_, 0, 1, 2, 3, 4, 5, 6, 7); } } \
    else { _Pragma("unroll") for (int n = 0; n < 2; ++n) _Pragma("unroll") for (int k = 0; k < 2; ++k) \
      dst[n][k] = *reinterpret_cast<const bf16x8*>((char*)SB(b, h) + lds_byte(wc * 32 + n * 16 + fr, k * 32 + fq * 8)); } } while (0)
#define MMA(ai, bj, At, Bv) do { __builtin_amdgcn_s_setprio(1); \
    if constexpr (F8) { _Pragma("unroll") for (int m = 0; m < 4; ++m) _Pragma("unroll") for (int n = 0; n < 2; ++n) \
        { acc[ai][bj][m][n] = __builtin_amdgcn_mfma_scale_f32_16x16x128_f8f6f4(Bv##8[n], At##8[m], acc[ai][bj][m][n], 0, 0, 0, 0x7f7f7f7f, 0, sc_b); \
          asm volatile("" : "+v"(acc[ai][bj][m][n])); } }   \
    else { _Pragma("unroll") for (int m = 0; m < 4; ++m) _Pragma("unroll") for (int n = 0; n < 2; ++n) _Pragma("unroll") for (int k = 0; k < 2; ++k) \
      acc[ai][bj][m][n] = __builtin_amdgcn_mfma_f32_16x16x32_bf16(Bv[n][k], At[m][k], acc[ai][bj][m][n], 0, 0, 0); } \
    __builtin_amdgcn_s_setprio(0); } while (0)
#define WAIT_V(n) asm volatile("s_waitcnt vmcnt(" #n ")" ::: "memory")
#define WAIT_L(n) asm volatile("s_waitcnt lgkmcnt(" #n ")" ::: "memory")
#define BAR __builtin_amdgcn_s_barrier()
#define SCHED __builtin_amdgcn_sched_barrier(0)
    int tz = threadIdx.x; asm volatile("" : "+v"(tz));
    int wid = tz >> 6, lane = tz & 63, wr = wid >> 2, wc = wid & 3, fr = lane & 15, fq = lane >> 4;
    f32x4 acc[2][2][4][2];
#pragma unroll
    for (int a = 0; a < 2; ++a)
#pragma unroll
        for (int b = 0; b < 2; ++b)
#pragma unroll
            for (int m = 0; m < 4; ++m)
#pragma unroll
                for (int n = 0; n < 2; ++n) acc[a][b][m][n] = (f32x4){0.f, 0.f, 0.f, 0.f};
#define ASC(kt) (SCM == 0 ? 0x7f7f7f7f : ((kt) < 8 ? 0x7a7a7a7a : ((kt) >= 12 ? (int)0x81818181 : 0x7f7f7f7f)))
    int sc_b = 0x7f7f7f7f;
    bf16x8 At[4][2], B0[2][2], B1[2][2]; i32x8 At8[4], B08[2], B18[2];
    const int nt = K / G_BK;
    STAGE_B(SB(0, 0), 0, 0); STAGE_A(SA(0, 0), 0, 0);
    STAGE_B(SB(0, 1), 1, 0); STAGE_A(SA(0, 1), 1, 0);
    if (wr == 1) BAR;
    WAIT_V(4); BAR;
    STAGE_B(SB(1, 0), 0, 1); STAGE_A(SA(1, 0), 0, 1); STAGE_B(SB(1, 1), 1, 1);
    WAIT_V(6); BAR;
    for (int t = 0; t < nt - 2; t += 2) {
        sc_b = ASC(t);
        LDB(B0, 0, 0); SCHED; LDA(At, 0, 0); STAGE_A(SA(1, 1), 1, t + 1);
        WAIT_L(8); BAR; WAIT_L(0); MMA(0, 0, At, B0); BAR; SCHED;
        LDB(B1, 0, 1); STAGE_B(SB(0, 0), 0, t + 2);
        BAR; WAIT_L(0); MMA(0, 1, At, B1); BAR;
        LDA(At, 0, 1); STAGE_A(SA(0, 0), 0, t + 2);
        BAR; WAIT_L(0); MMA(1, 0, At, B0); BAR; SCHED;
        STAGE_B(SB(0, 1), 1, t + 2);
        WAIT_V(6); BAR; MMA(1, 1, At, B1); BAR;
        sc_b = ASC(t + 1);
        LDB(B0, 1, 0); SCHED; LDA(At, 1, 0); STAGE_A(SA(0, 1), 1, t + 2);
        WAIT_L(8); BAR; WAIT_L(0); MMA(0, 0, At, B0); BAR; SCHED;
        LDB(B1, 1, 1); STAGE_B(SB(1, 0), 0, t + 3);
        BAR; WAIT_L(0); MMA(0, 1, At, B1); BAR;
        LDA(At, 1, 1); STAGE_A(SA(1, 0), 0, t + 3);
        BAR; WAIT_L(0); MMA(1, 0, At, B0); BAR; SCHED;
        STAGE_B(SB(1, 1), 1, t + 3);
        WAIT_V(6); BAR; MMA(1, 1, At, B1); BAR;
    }
    tz = threadIdx.x; asm volatile("" : "+v"(tz)); wid = tz >> 6; lane = tz & 63; wr = wid >> 2; wc = wid & 3; fr = lane & 15; fq = lane >> 4;
    sc_b = ASC(nt - 2);
    { LDB(B0, 0, 0); WAIT_V(0); LDA(At, 0, 0); STAGE_A(SA(1, 1), 1, nt - 1);
      BAR; WAIT_L(0); MMA(0, 0, At, B0); BAR;
      LDB(B1, 0, 1); BAR; WAIT_L(0); MMA(0, 1, At, B1); BAR;
      LDA(At, 0, 1); WAIT_V(4); BAR; WAIT_L(0); MMA(1, 0, At, B0); MMA(1, 1, At, B1); BAR; }
    sc_b = ASC(nt - 1);
    { LDB(B0, 1, 0); LDA(At, 1, 0); WAIT_V(2); BAR; WAIT_L(0); MMA(0, 0, At, B0); BAR;
      LDB(B1, 1, 1); WAIT_V(0); BAR; WAIT_L(0); MMA(0, 1, At, B1); BAR;
      LDA(At, 1, 1); BAR; WAIT_L(0); MMA(1, 0, At, B0); MMA(1, 1, At, B1); BAR; }
    if (wr == 0) BAR;
    if constexpr (F8) {
#pragma unroll
        for (int a = 0; a < 2; ++a)
#pragma unroll
            for (int b = 0; b < 2; ++b)
#pragma unroll
                for (int m = 0; m < 4; ++m)
#pragma unroll
                    for (int n = 0; n < 2; ++n) asm volatile("" : "+v"(acc[a][b][m][n]));
    }
    epi(acc, wr, wc, fr, fq);
    __syncthreads();
#undef SA
#undef SB
#undef STAGE_A
#undef STAGE_B
#undef LDA
#undef LDB
#undef MMA
#undef ASC
}
__device__ __forceinline__ void stage_coords(int& R0, int& C0) { stage_rc(otid() * 16, R0, C0); }

constexpr int A_KVBLK = 64;
constexpr size_t A_SHM_V = 64 * 128 * 2;
#define SBAR() __builtin_amdgcn_sched_barrier(0)
__device__ __forceinline__ int crow(int r, int hi) { return (r & 3) + 8 * (r >> 2) + 4 * hi; }
template <int DQK> __device__ __forceinline__ int kswz(int row, int colB) { return row * (DQK * 2) + (colB ^ ((row & 7) << 4)); }

template <int DQK>
__device__ __forceinline__ void partialSM(f32x16& p0, f32x16& p1, float& m_reg, float& mn, float& alpha) {
    constexpr float SCALE = (DQK == 128) ? 0.088388347648318440f : 0.072168783648703220f;
    constexpr float C = SCALE * 1.4426950408889634f;
    constexpr float THR = 8.f;
    float pmax = p0[0];
#pragma unroll
    for (int r = 1; r < 16; ++r) pmax = fmaxf(pmax, p0[r]);
#pragma unroll
    for (int r = 0; r < 16; ++r) pmax = fmaxf(pmax, p1[r]);
    { auto rr = __builtin_amdgcn_permlane32_swap(__float_as_uint(pmax), __float_as_uint(pmax), false, false);
      pmax = fmaxf(__uint_as_float(rr[0]), __uint_as_float(rr[1])); }
    if (__builtin_expect(__all(pmax - m_reg <= THR / SCALE), 1)) { mn = m_reg; alpha = 1.f; }
    else { mn = fmaxf(m_reg, pmax); alpha = __builtin_amdgcn_exp2f((m_reg - mn) * C); m_reg = mn; }
    float mnC = -mn * C;
#pragma unroll
    for (int r = 0; r < 16; ++r) p0[r] = fmaf(p0[r], C, mnC);
#pragma unroll
    for (int r = 0; r < 16; ++r) p1[r] = fmaf(p1[r], C, mnC);
#pragma unroll
    for (int r = 0; r < 16; ++r) p0[r] = __builtin_amdgcn_exp2f(p0[r]);
}
__device__ __forceinline__ void finishSM(f32x16& p0, f32x16& p1, float alpha, float& l_reg, bf16x8& pa0, bf16x8& pa1, bf16x8& pa2, bf16x8& pa3) {
#pragma unroll
    for (int r = 0; r < 16; ++r) p1[r] = __builtin_amdgcn_exp2f(p1[r]);
    float ps = 0;
#pragma unroll
    for (int r = 0; r < 16; ++r) ps += p0[r];
#pragma unroll
    for (int r = 0; r < 16; ++r) ps += p1[r];
    { auto rr = __builtin_amdgcn_permlane32_swap(__float_as_uint(ps), __float_as_uint(ps), false, false);
      ps = __uint_as_float(rr[0]) + __uint_as_float(rr[1]); }
    l_reg = l_reg * alpha + ps;
#define PK4(P, BASE, OUT) do { unsigned a0 = cvtpk(P[BASE + 0], P[BASE + 1]), a1 = cvtpk(P[BASE + 2], P[BASE + 3]);   \
    unsigned b0 = cvtpk(P[BASE + 4], P[BASE + 5]), b1 = cvtpk(P[BASE + 6], P[BASE + 7]);                              \
    auto r0 = __builtin_amdgcn_permlane32_swap(a0, b0, false, false); auto r1 = __builtin_amdgcn_permlane32_swap(a1, b1, false, false); \
    u32x4 w = {r0[0], r1[0], r0[1], r1[1]}; OUT = *reinterpret_cast<bf16x8*>(&w); } while (0)
    PK4(p0, 0, pa0); PK4(p0, 8, pa1); PK4(p1, 0, pa2); PK4(p1, 8, pa3);
#undef PK4
}
template <int DQK>
__device__ __forceinline__ void qkt(f32x16& p0, f32x16& p1, const char* Ks, const bf16x8* qr, int r32, int hi) {
    p0 = f32x16{}; p1 = f32x16{};
#pragma unroll
    for (int d0 = 0; d0 < DQK / 16; ++d0) { int cb = (d0 * 16 + hi * 8) * 2;
        bf16x8 b0 = *reinterpret_cast<const bf16x8*>(Ks + kswz<DQK>(r32, cb));
        bf16x8 b1 = *reinterpret_cast<const bf16x8*>(Ks + kswz<DQK>(32 + r32, cb));
        p0 = __builtin_amdgcn_mfma_f32_32x32x16_bf16(b0, qr[d0], p0, 0, 0, 0);
        p1 = __builtin_amdgcn_mfma_f32_32x32x16_bf16(b1, qr[d0], p1, 0, 0, 0); }
}
__device__ __forceinline__ int v_st(int k, int c) { const int kk = (k & ~0xC) | ((k & 4) << 1) | ((k & 8) >> 1); return ((kk >> 3) * 4 + (c >> 5)) * 512 + ((kk & 7) * 32 + (c & 31)) * 2; }
__device__ __forceinline__ int v_rd_base(int lane) { return ((lane & 3) << 3) | (((lane >> 2) & 3) << 6) | (((lane >> 4) & 1) << 5) | (((lane >> 5) & 1) << 8); }
constexpr int v_rd_off(int d0, int ks, int half) { return d0 * 512 + ks * 4096 + half * 2048; }
template <int OFF> __device__ __forceinline__ s16x4 tr_read(int vb) {
    s16x4 r; asm volatile("ds_read_b64_tr_b16 %0, %1 offset:%2" : "=&v"(r) : "v"(vb), "i"(OFF) : "memory"); return r;
}
template <int D0> __device__ __forceinline__ void pv_one(f32x16& od, int vb, bf16x8 pa0, bf16x8 pa1, bf16x8 pa2, bf16x8 pa3) {
    const s16x4 l0 = tr_read<v_rd_off(D0, 0, 0)>(vb), h0 = tr_read<v_rd_off(D0, 0, 1)>(vb), l1 = tr_read<v_rd_off(D0, 1, 0)>(vb), h1 = tr_read<v_rd_off(D0, 1, 1)>(vb);
    const s16x4 l2 = tr_read<v_rd_off(D0, 2, 0)>(vb), h2 = tr_read<v_rd_off(D0, 2, 1)>(vb), l3 = tr_read<v_rd_off(D0, 3, 0)>(vb), h3 = tr_read<v_rd_off(D0, 3, 1)>(vb);
    asm volatile("s_waitcnt lgkmcnt(0)" ::: "memory"); SBAR();
#define PKV(L, H) (bf16x8){L[0], L[1], L[2], L[3], H[0], H[1], H[2], H[3]}
    od = __builtin_amdgcn_mfma_f32_32x32x16_bf16(pa0, PKV(l0, h0), od, 0, 0, 0);
    od = __builtin_amdgcn_mfma_f32_32x32x16_bf16(pa1, PKV(l1, h1), od, 0, 0, 0);
    od = __builtin_amdgcn_mfma_f32_32x32x16_bf16(pa2, PKV(l2, h2), od, 0, 0, 0);
    od = __builtin_amdgcn_mfma_f32_32x32x16_bf16(pa3, PKV(l3, h3), od, 0, 0, 0);
#undef PKV
}
__device__ __forceinline__ void pv_d0(f32x16* o, int vb, bf16x8 pa0, bf16x8 pa1, bf16x8 pa2, bf16x8 pa3) {
    pv_one<0>(o[0], vb, pa0, pa1, pa2, pa3); pv_one<1>(o[1], vb, pa0, pa1, pa2, pa3); pv_one<2>(o[2], vb, pa0, pa1, pa2, pa3); pv_one<3>(o[3], vb, pa0, pa1, pa2, pa3);
}

template <int DQK, bool ROPEQ, int ldq, int ldk, int ldv, int ldo>
__device__ __forceinline__ void attn_unit(const bf16_t* __restrict__ Qb, const bf16_t* __restrict__ Kh, const bf16_t* __restrict__ Vh,
                                          bf16_t* __restrict__ Ob, int seq, int s0, bool do_rope, char* lds) {
    constexpr int ND = DQK / 16, NKP = DQK / 8, KPT = (64 * NKP) / 512;
    constexpr size_t SHM_K = 64 * DQK * 2;
    const int tid = otid(), wid = tid >> 6, lane = tid & 63, r32 = lane & 31, hi = lane >> 5;
    char* V_lds = lds; char* K_lds = lds + 2 * A_SHM_V;
    float* wsf = (float*)(lds + 2 * A_SHM_V + 2 * SHM_K) + wid * 64; float* li_l = wsf; float* al_l = wsf + 32;
    float m_reg = -1e30f, l_reg = 0; f32x16 o[4] = {}; bf16x8 qr[ND];
    const bf16_t* Qw = Qb + (long)(wid * 32 + r32) * ldq + hi * 8;
#pragma unroll
    for (int d0 = 0; d0 < ND; ++d0) qr[d0] = *reinterpret_cast<const bf16x8*>(Qw + d0 * 16);
    if constexpr (ROPEQ) {
        if (do_rope) {
            const int s = s0 + wid * 32 + r32; const float rp = (float)(s >> 6), cp = (float)(s & 63);
#pragma unroll
            for (int blk = 0; blk < 2; ++blk) {
                bf16x8 a = qr[8 + blk], bq = qr[10 + blk], oa, ob;
#pragma unroll
                for (int e = 0; e < 8; ++e) {
                    const int j = hi * 8 + e;
                    const float inv = powf(10000.f, -(float)j / 16.f);
                    float sn, cs; sincosf((blk == 0 ? rp : cp) * inv, &sn, &cs);
                    const float x1 = bf2f((bf16_t)a[e]), x2 = bf2f((bf16_t)bq[e]);
                    oa[e] = (short)f2bf(x1 * cs - x2 * sn); ob[e] = (short)f2bf(x2 * cs + x1 * sn);
                }
                qr[8 + blk] = oa; qr[10 + blk] = ob;
            }
        }
    }
    const int sr = tid >> 4, sc = (tid & 15) * 8, vst0 = v_st(sr, sc), vst1 = v_st(32 + sr, sc);
    const int vb0 = (int)(uintptr_t)V_lds + v_rd_base(lane);
    const unsigned voff = sr * ldv + sc;
    unsigned koff[KPT]; int kst[KPT];
#pragma unroll
    for (int i = 0; i < KPT; ++i) { const int p = tid + 512 * i, kr_ = p / NKP, kc_ = (p % NKP) * 8; koff[i] = kr_ * ldk + kc_; kst[i] = kswz<DQK>(kr_, kc_ * 2); }
    struct { bf16x8 vs0, vs1, ks[KPT]; } sr_[2];
#define SLOAD(i, k0) do { const bf16_t* vb_ = Vh + (long)(k0) * ldv; const bf16_t* kb_ = Kh + (long)(k0) * ldk; \
    sr_[i].vs0 = *reinterpret_cast<const bf16x8*>(vb_ + voff); sr_[i].vs1 = *reinterpret_cast<const bf16x8*>(vb_ + 32 * ldv + voff); \
    _Pragma("unroll") for (int i_ = 0; i_ < KPT; ++i_) sr_[i].ks[i_] = *reinterpret_cast<const bf16x8*>(kb_ + koff[i_]); } while (0)
#define SWRITE(b, i) do { *(bf16x8*)(V_lds + (b) * A_SHM_V + vst0) = sr_[i].vs0; *(bf16x8*)(V_lds + (b) * A_SHM_V + vst1) = sr_[i].vs1; \
    _Pragma("unroll") for (int i_ = 0; i_ < KPT; ++i_) *(bf16x8*)(K_lds + (b) * SHM_K + kst[i_]) = sr_[i].ks[i_]; } while (0)
#define SWAIT() asm volatile("s_waitcnt vmcnt(%0)" :: "n"(2 + KPT) : "memory")
#define RESC(a) do { if (__any((a) < 1.f)) { if (hi == 0) al_l[r32] = (a); asm volatile("s_waitcnt lgkmcnt(0)" ::: "memory"); \
    _Pragma("unroll") for (int d = 0; d < 4; ++d) _Pragma("unroll") for (int r = 0; r < 16; ++r) o[d][r] *= al_l[crow(r, hi)]; } } while (0)
    f32x16 pA0, pA1, pB0, pB1; float mnA, mnB, alA, alB; bf16x8 pa0, pa1, pa2, pa3; const int NT = seq / A_KVBLK;
    constexpr int SE = 0, SO = 1;
    SLOAD(SE, 0); asm volatile("s_waitcnt vmcnt(0)" ::: "memory"); SWRITE(0, SE); __syncthreads();
    qkt<DQK>(pA0, pA1, K_lds, qr, r32, hi); partialSM<DQK>(pA0, pA1, m_reg, mnA, alA);
    SLOAD(SO, A_KVBLK); if (2 < NT) SLOAD(SE, 2 * A_KVBLK);
    SWAIT(); SWRITE(1, SO); __syncthreads();
    for (int j = 1; j + 1 < NT; j += 2) {
        SBAR(); qkt<DQK>(pB0, pB1, K_lds + SHM_K, qr, r32, hi);
        finishSM(pA0, pA1, alA, l_reg, pa0, pa1, pa2, pa3); SBAR();
        SLOAD(SO, (j + 2) * A_KVBLK); SBAR();
        pv_d0(o, vb0, pa0, pa1, pa2, pa3); partialSM<DQK>(pB0, pB1, m_reg, mnB, alB);
        __syncthreads(); SWAIT(); SWRITE(0, SE);
        RESC(alB); __syncthreads();
        SBAR(); qkt<DQK>(pA0, pA1, K_lds, qr, r32, hi);
        finishSM(pB0, pB1, alB, l_reg, pa0, pa1, pa2, pa3); SBAR();
        if (j + 3 < NT) SLOAD(SE, (j + 3) * A_KVBLK); SBAR();
        pv_d0(o, vb0 + (int)A_SHM_V, pa0, pa1, pa2, pa3); partialSM<DQK>(pA0, pA1, m_reg, mnA, alA);
        __syncthreads(); SWAIT(); SWRITE(1, SO);
        RESC(alA); __syncthreads();
    }
    SBAR(); qkt<DQK>(pB0, pB1, K_lds + SHM_K, qr, r32, hi);
    finishSM(pA0, pA1, alA, l_reg, pa0, pa1, pa2, pa3); SBAR();
    pv_d0(o, vb0, pa0, pa1, pa2, pa3); partialSM<DQK>(pB0, pB1, m_reg, mnB, alB);
    __syncthreads(); RESC(alB);
    finishSM(pB0, pB1, alB, l_reg, pa0, pa1, pa2, pa3); SBAR();
    pv_d0(o, vb0 + (int)A_SHM_V, pa0, pa1, pa2, pa3);
    if (hi == 0) li_l[r32] = l_reg; asm volatile("s_waitcnt lgkmcnt(0)" ::: "memory");
    float rli[16];
#pragma unroll
    for (int r = 0; r < 16; ++r) rli[r] = __builtin_amdgcn_rcpf(li_l[crow(r, hi)]);
    bf16_t* Ow = Ob + (long)(wid * 32) * ldo;
#pragma unroll
    for (int r = 0; r < 16; ++r) { const int orow = crow(r, hi);
#pragma unroll
        for (int d0 = 0; d0 < 4; ++d0) Ow[(long)orow * ldo + d0 * 32 + r32] = f2bf(o[d0][r] * rli[r]); }
    __syncthreads();
#undef SLOAD
#undef SWRITE
#undef SWAIT
#undef RESC
}

template <int DQK, bool ROPEQ, int ldq, int ldk, int ldv, int ldo>
__device__ __forceinline__ void attn_unit_s(const bf16_t* __restrict__ Qb, const bf16_t* __restrict__ Kh, const bf16_t* __restrict__ Vh,
                                            bf16_t* __restrict__ Ob, int seq, int s0, bool do_rope, char* lds) {
    constexpr int ND = DQK / 16, NKP = DQK / 8, KPT = (64 * NKP) / 512;
    constexpr size_t SHM_K = 64 * DQK * 2;
    const int tid = otid(), wid = tid >> 6, lane = tid & 63, r32 = lane & 31, hi = lane >> 5;
    char* V_lds = lds; char* K_lds = lds + 2 * A_SHM_V;
    float* wsf = (float*)(lds + 2 * A_SHM_V + 2 * SHM_K) + wid * 64; float* li_l = wsf; float* al_l = wsf + 32;
    float m_reg = -1e30f, l_reg = 0; f32x16 o[4] = {}; bf16x8 qr[ND];
    const bf16_t* Qw = Qb + (long)(wid * 32 + r32) * ldq + hi * 8;
#pragma unroll
    for (int d0 = 0; d0 < ND; ++d0) qr[d0] = *reinterpret_cast<const bf16x8*>(Qw + d0 * 16);
    if constexpr (ROPEQ) {
        if (do_rope) {
            const int s = s0 + wid * 32 + r32; const float rp = (float)(s >> 6), cp = (float)(s & 63);
#pragma unroll
            for (int blk = 0; blk < 2; ++blk) {
                bf16x8 a = qr[8 + blk], bq = qr[10 + blk], oa, ob;
#pragma unroll
                for (int e = 0; e < 8; ++e) {
                    const int j = hi * 8 + e;
                    const float inv = powf(10000.f, -(float)j / 16.f);
                    float sn, cs; sincosf((blk == 0 ? rp : cp) * inv, &sn, &cs);
                    const float x1 = bf2f((bf16_t)a[e]), x2 = bf2f((bf16_t)bq[e]);
                    oa[e] = (short)f2bf(x1 * cs - x2 * sn); ob[e] = (short)f2bf(x2 * cs + x1 * sn);
                }
                qr[8 + blk] = oa; qr[10 + blk] = ob;
            }
        }
    }
    const int sr = tid >> 4, sc = (tid & 15) * 8, vst0 = v_st(sr, sc), vst1 = v_st(32 + sr, sc);
    const int vb0 = (int)(uintptr_t)V_lds + v_rd_base(lane);
    const unsigned voff = sr * ldv + sc;
    unsigned koff[KPT]; int kst[KPT];
#pragma unroll
    for (int i = 0; i < KPT; ++i) { const int p = tid + 512 * i, kr_ = p / NKP, kc_ = (p % NKP) * 8; koff[i] = kr_ * ldk + kc_; kst[i] = kswz<DQK>(kr_, kc_ * 2); }
    bf16x8 vs0, vs1, ks[KPT];
#define SLOAD(k0) do { const bf16_t* vb_ = Vh + (long)(k0) * ldv; const bf16_t* kb_ = Kh + (long)(k0) * ldk; \
    vs0 = *reinterpret_cast<const bf16x8*>(vb_ + voff); vs1 = *reinterpret_cast<const bf16x8*>(vb_ + 32 * ldv + voff); \
    _Pragma("unroll") for (int i_ = 0; i_ < KPT; ++i_) ks[i_] = *reinterpret_cast<const bf16x8*>(kb_ + koff[i_]); } while (0)
#define SWRITE(b) do { *(bf16x8*)(V_lds + (b) * A_SHM_V + vst0) = vs0; *(bf16x8*)(V_lds + (b) * A_SHM_V + vst1) = vs1; \
    _Pragma("unroll") for (int i_ = 0; i_ < KPT; ++i_) *(bf16x8*)(K_lds + (b) * SHM_K + kst[i_]) = ks[i_]; } while (0)
    const int NT = seq / A_KVBLK;
    SLOAD(0); asm volatile("s_waitcnt vmcnt(0)" ::: "memory"); SWRITE(0); __syncthreads();
    SLOAD(A_KVBLK);
#pragma unroll 1
    for (int j = 0; j < NT; ++j) {
        const int buf = j & 1;
        f32x16 p0, p1; float mn, alpha; bf16x8 pa0, pa1, pa2, pa3;
        qkt<DQK>(p0, p1, K_lds + buf * SHM_K, qr, r32, hi);
        partialSM<DQK>(p0, p1, m_reg, mn, alpha);
        finishSM(p0, p1, alpha, l_reg, pa0, pa1, pa2, pa3);
        if (__any(alpha < 1.f)) { if (hi == 0) al_l[r32] = alpha; asm volatile("s_waitcnt lgkmcnt(0)" ::: "memory");
#pragma unroll
            for (int d = 0; d < 4; ++d)
#pragma unroll
                for (int r = 0; r < 16; ++r) o[d][r] *= al_l[crow(r, hi)]; }
        if (j + 1 < NT) SWRITE(buf ^ 1);
        SBAR();
        pv_d0(o, vb0 + buf * (int)A_SHM_V, pa0, pa1, pa2, pa3);
        __syncthreads();
        if (j + 2 < NT) SLOAD((j + 2) * A_KVBLK);
    }
    if (hi == 0) li_l[r32] = l_reg; asm volatile("s_waitcnt lgkmcnt(0)" ::: "memory");
    float rli[16];
#pragma unroll
    for (int r = 0; r < 16; ++r) rli[r] = __builtin_amdgcn_rcpf(li_l[crow(r, hi)]);
    bf16_t* Ow = Ob + (long)(wid * 32) * ldo;
#pragma unroll
    for (int r = 0; r < 16; ++r) { const int orow = crow(r, hi);
#pragma unroll
        for (int d0 = 0; d0 < 4; ++d0) Ow[(long)orow * ldo + d0 * 32 + r32] = f2bf(o[d0][r] * rli[r]); }
    __syncthreads();
#undef SLOAD
#undef SWRITE
}

template <int DQK, bool ROPEQ, int ldq, int ldk, int ldv, int ldo>
__device__ __forceinline__ void attn_unit_pp(const bf16_t* __restrict__ Qb, const bf16_t* __restrict__ Kh, const bf16_t* __restrict__ Vh,
                                             bf16_t* __restrict__ Ob, int seq, int s0, bool do_rope, char* lds) {
    constexpr int ND = DQK / 16, NKP = DQK / 8, KPT = (64 * NKP) / 512;
    constexpr size_t SHM_K = 64 * DQK * 2;
    const int tid = otid(), wid = tid >> 6, lane = tid & 63, r32 = lane & 31, hi = lane >> 5, half = wid >> 2;
    char* V_lds = lds; char* K_lds = lds + 2 * A_SHM_V;
    float* wsf = (float*)(lds + 2 * A_SHM_V + 2 * SHM_K) + wid * 64; float* li_l = wsf; float* al_l = wsf + 32;
    float m_reg = -1e30f, l_reg = 0; f32x16 o[4] = {}; bf16x8 qr[ND];
    const bf16_t* Qw = Qb + (long)(wid * 32 + r32) * ldq + hi * 8;
#pragma unroll
    for (int d0 = 0; d0 < ND; ++d0) qr[d0] = *reinterpret_cast<const bf16x8*>(Qw + d0 * 16);
    if constexpr (ROPEQ) {
        if (do_rope) {
            const int s = s0 + wid * 32 + r32; const float rp = (float)(s >> 6), cp = (float)(s & 63);
#pragma unroll
            for (int blk = 0; blk < 2; ++blk) {
                bf16x8 a = qr[8 + blk], bq = qr[10 + blk], oa, ob;
#pragma unroll
                for (int e = 0; e < 8; ++e) {
                    const int j = hi * 8 + e;
                    const float inv = powf(10000.f, -(float)j / 16.f);
                    float sn, cs; sincosf((blk == 0 ? rp : cp) * inv, &sn, &cs);
                    const float x1 = bf2f((bf16_t)a[e]), x2 = bf2f((bf16_t)bq[e]);
                    oa[e] = (short)f2bf(x1 * cs - x2 * sn); ob[e] = (short)f2bf(x2 * cs + x1 * sn);
                }
                qr[8 + blk] = oa; qr[10 + blk] = ob;
            }
        }
    }
    const int sr = tid >> 4, sc = (tid & 15) * 8, vst0 = v_st(sr, sc), vst1 = v_st(32 + sr, sc);
    const int vb0 = (int)(uintptr_t)V_lds + v_rd_base(lane);
    const unsigned voff = sr * ldv + sc;
    unsigned koff[KPT]; int kst[KPT];
#pragma unroll
    for (int i = 0; i < KPT; ++i) { const int p = tid + 512 * i, kr_ = p / NKP, kc_ = (p % NKP) * 8; koff[i] = kr_ * ldk + kc_; kst[i] = kswz<DQK>(kr_, kc_ * 2); }
    bf16x8 vs0, vs1, ks[KPT];
#define LOADK(k0) do { const bf16_t* kb_ = Kh + (long)(k0) * ldk; _Pragma("unroll") for (int i_ = 0; i_ < KPT; ++i_) ks[i_] = *reinterpret_cast<const bf16x8*>(kb_ + koff[i_]); } while (0)
#define LOADV(k0) do { const bf16_t* vb_ = Vh + (long)(k0) * ldv; vs0 = *reinterpret_cast<const bf16x8*>(vb_ + voff); vs1 = *reinterpret_cast<const bf16x8*>(vb_ + 32 * ldv + voff); } while (0)
#define WRITEK(b) do { _Pragma("unroll") for (int i_ = 0; i_ < KPT; ++i_) *(bf16x8*)(K_lds + (b) * SHM_K + kst[i_]) = ks[i_]; } while (0)
#define WRITEV(b) do { *(bf16x8*)(V_lds + (b) * A_SHM_V + vst0) = vs0; *(bf16x8*)(V_lds + (b) * A_SHM_V + vst1) = vs1; } while (0)
#define RAWBAR() do { asm volatile("s_waitcnt lgkmcnt(0)" ::: "memory"); __builtin_amdgcn_s_barrier(); asm volatile("" ::: "memory"); } while (0)
    const int NT = seq / A_KVBLK;
    LOADK(0); asm volatile("s_waitcnt vmcnt(0)" ::: "memory"); WRITEK(0);
    LOADK(A_KVBLK); LOADV(0);
    __syncthreads();
    if (half == 1) RAWBAR();
    f32x16 p0, p1; float mn, alpha; bf16x8 pa0, pa1, pa2, pa3;
#pragma unroll 1
    for (int x = 0; x < NT; ++x) {
        __builtin_amdgcn_s_setprio(1);
        qkt<DQK>(p0, p1, K_lds + (x & 1) * SHM_K, qr, r32, hi);
        if (x > 0) pv_d0(o, vb0 + ((x - 1) & 1) * (int)A_SHM_V, pa0, pa1, pa2, pa3);
        __builtin_amdgcn_s_setprio(0);
        if (x + 1 < NT) WRITEK((x + 1) & 1);
        WRITEV(x & 1);
        if (x + 2 < NT) LOADK((x + 2) * A_KVBLK);
        if (x + 1 < NT) LOADV((x + 1) * A_KVBLK);
        RAWBAR();
        partialSM<DQK>(p0, p1, m_reg, mn, alpha);
        finishSM(p0, p1, alpha, l_reg, pa0, pa1, pa2, pa3);
        if (__any(alpha < 1.f)) { if (hi == 0) al_l[r32] = alpha; asm volatile("s_waitcnt lgkmcnt(0)" ::: "memory");
#pragma unroll
            for (int d = 0; d < 4; ++d)
#pragma unroll
                for (int r = 0; r < 16; ++r) o[d][r] *= al_l[crow(r, hi)]; }
        RAWBAR();
    }
    pv_d0(o, vb0 + ((NT - 1) & 1) * (int)A_SHM_V, pa0, pa1, pa2, pa3);
    if (half == 0) RAWBAR();
    if (hi == 0) li_l[r32] = l_reg; asm volatile("s_waitcnt lgkmcnt(0)" ::: "memory");
    float rli[16];
#pragma unroll
    for (int r = 0; r < 16; ++r) rli[r] = __builtin_amdgcn_rcpf(li_l[crow(r, hi)]);
    bf16_t* Ow = Ob + (long)(wid * 32) * ldo;
#pragma unroll
    for (int r = 0; r < 16; ++r) { const int orow = crow(r, hi);
#pragma unroll
        for (int d0 = 0; d0 < 4; ++d0) Ow[(long)orow * ldo + d0 * 32 + r32] = f2bf(o[d0][r] * rli[r]); }
    __syncthreads();
#undef LOADK
#undef LOADV
#undef WRITEK
#undef WRITEV
#undef RAWBAR
}

template <int DQK> __device__ __forceinline__ int k8_addr(int row, int chunk) {
    if constexpr (DQK == 192) return row * 256 + ((chunk ^ (row & 15)) << 4);
    else return row * 128 + ((chunk ^ ((row >> 1) & 7)) << 4);
}
__device__ __forceinline__ int vt_addr(int col, int chunk) { return col * 64 + ((chunk ^ ((col >> 2) & 3)) << 4); }
template <int DQK, bool ROPEQ, int ldq, int ldk8, int ldo>
__device__ __forceinline__ void attn_unit_f8(const bf16_t* __restrict__ Qb, const unsigned char* __restrict__ K8, const unsigned char* __restrict__ VT,
                                             unsigned char* __restrict__ Ob, int seq, int s0, bool do_rope, char* lds) {
    constexpr int NS = DQK / 64, NKP = DQK / 16, KROW = DQK == 192 ? 256 : 128;
    constexpr int SHM_K8 = 128 * KROW, SHM_VT = 16384;
    constexpr int KPT = (128 * NKP) / 512;
    constexpr float SCALE = (DQK == 128) ? 0.088388347648318440f : 0.072168783648703220f;
    constexpr float C = SCALE * 1.4426950408889634f, THR = 1.5f;
    const int tid = otid(), wid = tid >> 6, lane = tid & 63, r32 = lane & 31, hi = lane >> 5;
    char* K_lds = lds; char* V_lds = lds + 2 * SHM_K8;
    float* al_l = (float*)(lds + 2 * SHM_K8 + 2 * SHM_VT) + wid * 32;
    float m_reg = -1e30f, l_reg = 0.f; f32x16 o[4];
    { float z0 = 0.f; asm volatile("" : "+v"(z0));
#pragma unroll
      for (int d = 0; d < 4; ++d)
#pragma unroll
          for (int r = 0; r < 16; ++r) o[d][r] = z0; }
    constexpr int KD = SHM_K8 / 8192, CH = KROW / 16;
    unsigned kgo[KD];
#pragma unroll
    for (int i_ = 0; i_ < KD; ++i_) { const int slot = tid + 512 * i_, row = slot / CH, pos = slot % CH; int chunk = pos ^ (DQK == 192 ? (row & 15) : ((row >> 1) & 7)); if (chunk >= NKP) chunk = 0; kgo[i_] = row * ldk8 + chunk * 16; }
    const unsigned vgo = (tid >> 2) * 64 + (((tid & 3) ^ ((tid >> 4) & 3)) << 4);
#define DMA8(b, k0) do { const unsigned char* kb_ = K8 + (long)(k0) * ldk8; const unsigned char* vb_ = VT + (long)((k0) >> 6) * 8192 + vgo; \
    _Pragma("unroll") for (int i_ = 0; i_ < KD; ++i_) __builtin_amdgcn_global_load_lds((const unsigned*)(kb_ + kgo[i_]), (unsigned*)(K_lds + (b) * SHM_K8 + i_ * 8192 + tid * 16), 16, 0, 0); \
    __builtin_amdgcn_global_load_lds((const unsigned*)(vb_), (unsigned*)(V_lds + (b) * SHM_VT + tid * 16), 16, 0, 0); \
    __builtin_amdgcn_global_load_lds((const unsigned*)(vb_ + 8192), (unsigned*)(V_lds + (b) * SHM_VT + 8192 + tid * 16), 16, 0, 0); } while (0)
    DMA8(0, 0);
    i32x8 qf[NS];
    {
        const bf16_t* Qw = Qb + (long)(wid * 32 + r32) * ldq + hi * 32;
#pragma unroll
        for (int sidx = 0; sidx < NS; ++sidx) {
            float qv[32];
#pragma unroll
            for (int c8 = 0; c8 < 4; ++c8) { const bf16x8 t = *reinterpret_cast<const bf16x8*>(Qw + sidx * 64 + c8 * 8);
#pragma unroll
                for (int e = 0; e < 8; ++e) qv[c8 * 8 + e] = bf2f((bf16_t)t[e]); }
            if constexpr (ROPEQ) {
                if (sidx == 2 && do_rope) {
                    const int sq = s0 + wid * 32 + r32; const float rp = (float)(sq >> 6), cp = (float)(sq & 63);
#pragma unroll
                    for (int e = 0; e < 32; ++e) {
                        constexpr float IFR[16] = {1.591549431e-01f, 8.949976069e-02f, 5.032921210e-02f, 2.830207916e-02f, 1.591549431e-02f, 8.949976069e-03f, 5.032921210e-03f, 2.830207916e-03f, 1.591549431e-03f, 8.949976069e-04f, 5.032921210e-04f, 2.830207916e-04f, 1.591549431e-04f, 8.949976069e-05f, 5.032921210e-05f, 2.830207916e-05f};
                        const float rev = (e < 16 ? rp : cp) * IFR[e & 15];
                        const float sn = __builtin_amdgcn_sinf(rev), cs = __builtin_amdgcn_cosf(rev);
                        const float other = half_other(qv[e], hi == 0);
                        qv[e] = hi == 0 ? qv[e] * cs - other * sn : qv[e] * cs + other * sn;
                    }
                }
            }
#pragma unroll
            for (int v = 0; v < 8; ++v) qf[sidx][v] = (int)f2f8x4(qv[4 * v], qv[4 * v + 1], qv[4 * v + 2], qv[4 * v + 3]);
        }
    }
    const char* kp[NS][2]; const char* vp[2];
#pragma unroll
    for (int sidx = 0; sidx < NS; ++sidx)
#pragma unroll
        for (int e = 0; e < 2; ++e) kp[sidx][e] = K_lds + k8_addr<DQK>(r32, 4 * sidx + 2 * hi + e);
#pragma unroll
    for (int e = 0; e < 2; ++e) vp[e] = V_lds + vt_addr(r32, 2 * hi + e);
    const int NT = seq / 128;
    asm volatile("s_waitcnt vmcnt(0)" ::: "memory"); __syncthreads();
#define F8_SUB(BUF, T2) do { \
        f32x16 p0 = {}, p1 = {}; \
        _Pragma("unroll") for (int sidx = 0; sidx < NS; ++sidx) { \
            const i32x4 a0 = *reinterpret_cast<const i32x4*>(kp[sidx][0] + (BUF) * SHM_K8 + (2 * (T2)) * 32 * KROW), a1 = *reinterpret_cast<const i32x4*>(kp[sidx][1] + (BUF) * SHM_K8 + (2 * (T2)) * 32 * KROW); \
            const i32x4 b0 = *reinterpret_cast<const i32x4*>(kp[sidx][0] + (BUF) * SHM_K8 + (2 * (T2) + 1) * 32 * KROW), b1 = *reinterpret_cast<const i32x4*>(kp[sidx][1] + (BUF) * SHM_K8 + (2 * (T2) + 1) * 32 * KROW); \
            p0 = __builtin_amdgcn_mfma_scale_f32_32x32x64_f8f6f4(__builtin_shufflevector(a0, a1, 0, 1, 2, 3, 4, 5, 6, 7), qf[sidx], p0, 0, 0, 0, 0x7f7f7f7f, 0, 0x7f7f7f7f); \
            p1 = __builtin_amdgcn_mfma_scale_f32_32x32x64_f8f6f4(__builtin_shufflevector(b0, b1, 0, 1, 2, 3, 4, 5, 6, 7), qf[sidx], p1, 0, 0, 0, 0x7f7f7f7f, 0, 0x7f7f7f7f); } \
        float pm0 = __builtin_amdgcn_fmed3f(p0[0], p0[1], __builtin_inff()), pm1 = __builtin_amdgcn_fmed3f(p1[0], p1[1], __builtin_inff());     \
        _Pragma("unroll") for (int r = 2; r < 16; ++r) { pm0 = __builtin_amdgcn_fmed3f(pm0, p0[r], __builtin_inff()); pm1 = __builtin_amdgcn_fmed3f(pm1, p1[r], __builtin_inff()); } \
        float pmax = __builtin_amdgcn_fmed3f(pm0, pm1, __builtin_inff()); \
        { auto rr = __builtin_amdgcn_permlane32_swap(__float_as_uint(pmax), __float_as_uint(pmax), false, false); pmax = fmaxf(__uint_as_float(rr[0]), __uint_as_float(rr[1])); } \
        float alpha = 1.f; \
        if (!__builtin_expect(__all(pmax - m_reg <= THR / SCALE), 1)) { const float mn = fmaxf(m_reg, pmax); alpha = __builtin_amdgcn_exp2f((m_reg - mn) * C); m_reg = mn; } \
        const float mnC = 6.f - m_reg * C; \
        float ps = 0.f; \
        _Pragma("unroll") for (int r = 0; r < 16; ++r) { p0[r] = __builtin_amdgcn_exp2f(fmaf(p0[r], C, mnC)); p1[r] = __builtin_amdgcn_exp2f(fmaf(p1[r], C, mnC)); ps += p0[r] + p1[r]; } \
        l_reg = l_reg * alpha + half_sum(ps); \
        i32x8 pf; \
        _Pragma("unroll") for (int v = 0; v < 4; ++v) { pf[v] = (int)f2f8x4(p0[4 * v], p0[4 * v + 1], p0[4 * v + 2], p0[4 * v + 3]); pf[4 + v] = (int)f2f8x4(p1[4 * v], p1[4 * v + 1], p1[4 * v + 2], p1[4 * v + 3]); } \
        if (__any(alpha < 1.f)) { if (hi == 0) al_l[r32] = alpha; asm volatile("s_waitcnt lgkmcnt(0)" ::: "memory"); \
            _Pragma("unroll") for (int d = 0; d < 4; ++d) _Pragma("unroll") for (int r = 0; r < 16; ++r) o[d][r] *= al_l[crow(r, hi)]; } \
        _Pragma("unroll") for (int d0 = 0; d0 < 4; ++d0) { \
            const i32x4 v0 = *reinterpret_cast<const i32x4*>(vp[0] + (BUF) * SHM_VT + (T2) * 8192 + d0 * 2048), v1 = *reinterpret_cast<const i32x4*>(vp[1] + (BUF) * SHM_VT + (T2) * 8192 + d0 * 2048); \
            o[d0] = __builtin_amdgcn_mfma_scale_f32_32x32x64_f8f6f4(pf, __builtin_shufflevector(v0, v1, 0, 1, 2, 3, 4, 5, 6, 7), o[d0], 0, 0, 0, 0x7f7f7f7f, 0, 0x7f7f7f7f); } \
    } while (0)
#define F8_TILE(BUF, J) do { \
        if ((J) + 1 < NT) DMA8((BUF) ^ 1, ((J) + 1) * 128);        \
        F8_SUB(BUF, 0); __builtin_amdgcn_sched_barrier(0); F8_SUB(BUF, 1); \
        asm volatile("s_waitcnt vmcnt(0)" ::: "memory"); __syncthreads(); \
    } while (0)
    if (wid >= 4) __builtin_amdgcn_s_setprio(1);
#pragma unroll 1
    for (int j = 0; j < NT; j += 2) { F8_TILE(0, j); F8_TILE(1, j + 1); }
    __builtin_amdgcn_s_setprio(0);
    unsigned char* Ow = Ob + (long)(wid * 32) * ldo;
    if (hi == 0) al_l[r32] = l_reg; asm volatile("s_waitcnt lgkmcnt(0)" ::: "memory");
#pragma unroll
    for (int r = 0; r < 16; ++r) { const int orow = crow(r, hi); const float rl = 32.f * __builtin_amdgcn_rcpf(al_l[orow]);
#pragma unroll
        for (int d0 = 0; d0 < 4; ++d0) Ow[(long)orow * ldo + d0 * 32 + r32] = f2f8(o[d0][r] * rl); }
    __syncthreads();
#undef DMA8
#undef F8_TILE
#undef F8_SUB
}

template <int DQK, bool ROPEQ, int ldq, int ldk8, int ldo, int KSTEP>
__device__ __forceinline__ void attn_unit_f8h(const bf16_t* __restrict__ Qb, const unsigned char* __restrict__ K8, const unsigned char* __restrict__ VT,
                                             unsigned char* __restrict__ Ob, int seq, int s0, bool do_rope, char* lds) {
    constexpr int NS = DQK / 64, NKP = DQK / 16, KROW = DQK == 192 ? 256 : 128;
    constexpr int NSUB = KSTEP / 64, SHM_K8 = KSTEP * KROW, SHM_VT = NSUB * 8192, HB = 2 * (SHM_K8 + SHM_VT);
    constexpr float SCALE = (DQK == 128) ? 0.088388347648318440f : 0.072168783648703220f;
    constexpr float C = SCALE * 1.4426950408889634f, THR = 1.5f;
    const int tid = otid(), wid = tid >> 6, lane = tid & 63, r32 = lane & 31, hi = lane >> 5, half = wid >> 2, tl = tid & 255;
    char* K_lds = lds + half * HB; char* V_lds = K_lds + 2 * SHM_K8;
    float* al_l = (float*)(lds + 2 * HB) + wid * 32;
    volatile LAS unsigned* hcnt = (volatile LAS unsigned*)(lds + 2 * HB + 1024) + half * 16;
    unsigned htarget = 0u;
    float m_reg = -1e30f, l_reg = 0.f; f32x16 o[4];
    { float z0 = 0.f; asm volatile("" : "+v"(z0));
#pragma unroll
      for (int d = 0; d < 4; ++d)
#pragma unroll
          for (int r = 0; r < 16; ++r) o[d][r] = z0; }
    i32x8 qf[NS];
    {
        const bf16_t* Qw = Qb + (long)(wid * 32 + r32) * ldq + hi * 32;
#pragma unroll
        for (int sidx = 0; sidx < NS; ++sidx) {
            float qv[32];
#pragma unroll
            for (int c8 = 0; c8 < 4; ++c8) { const bf16x8 t = *reinterpret_cast<const bf16x8*>(Qw + sidx * 64 + c8 * 8);
#pragma unroll
                for (int e = 0; e < 8; ++e) qv[c8 * 8 + e] = bf2f((bf16_t)t[e]); }
            if constexpr (ROPEQ) {
                if (sidx == 2 && do_rope) {
                    const int sq = s0 + wid * 32 + r32; const float rp = (float)(sq >> 6), cp = (float)(sq & 63);
#pragma unroll
                    for (int e = 0; e < 32; ++e) {
                        constexpr float IFR[16] = {1.591549431e-01f, 8.949976069e-02f, 5.032921210e-02f, 2.830207916e-02f, 1.591549431e-02f, 8.949976069e-03f, 5.032921210e-03f, 2.830207916e-03f, 1.591549431e-03f, 8.949976069e-04f, 5.032921210e-04f, 2.830207916e-04f, 1.591549431e-04f, 8.949976069e-05f, 5.032921210e-05f, 2.830207916e-05f};
                        const float rev = (e < 16 ? rp : cp) * IFR[e & 15];
                        const float sn = __builtin_amdgcn_sinf(rev), cs = __builtin_amdgcn_cosf(rev);
                        const float other = half_other(qv[e], hi == 0);
                        qv[e] = hi == 0 ? qv[e] * cs - other * sn : qv[e] * cs + other * sn;
                    }
                }
            }
#pragma unroll
            for (int v = 0; v < 8; ++v) qf[sidx][v] = (int)f2f8x4(qv[4 * v], qv[4 * v + 1], qv[4 * v + 2], qv[4 * v + 3]);
        }
    }
    constexpr int KD = SHM_K8 / 4096, VD = SHM_VT / 4096, CH = KROW / 16;
    unsigned kgo[KD], vgo[VD];
#pragma unroll
    for (int i_ = 0; i_ < KD; ++i_) { const int slot = tl + 256 * i_, row = slot / CH, pos = slot % CH; int chunk = pos ^ (DQK == 192 ? (row & 15) : ((row >> 1) & 7)); if (chunk >= NKP) chunk = 0; kgo[i_] = row * ldk8 + chunk * 16; }
#pragma unroll
    for (int i_ = 0; i_ < VD; ++i_) { const int slot = tl + 256 * i_, t2 = slot >> 9, wi = slot & 511, col = wi >> 2; vgo[i_] = t2 * 8192 + col * 64 + (((wi & 3) ^ ((col >> 2) & 3)) << 4); }
#define DMA8(b, k0) do { const unsigned char* kb_ = K8 + (long)(k0) * ldk8; const unsigned char* vb_ = VT + (long)((k0) >> 6) * 8192; \
    _Pragma("unroll") for (int i_ = 0; i_ < KD; ++i_) __builtin_amdgcn_global_load_lds((const unsigned*)(kb_ + kgo[i_]), (unsigned*)(K_lds + (b) * SHM_K8 + i_ * 4096 + tl * 16), 16, 0, 0); \
    _Pragma("unroll") for (int i_ = 0; i_ < VD; ++i_) __builtin_amdgcn_global_load_lds((const unsigned*)(vb_ + vgo[i_]), (unsigned*)(V_lds + (b) * SHM_VT + i_ * 4096 + tl * 16), 16, 0, 0); } while (0)
#define HBAR() do { asm volatile("s_waitcnt vmcnt(0) lgkmcnt(0)" ::: "memory"); \
    if (lane == 0) __hip_atomic_fetch_add((LAS unsigned*)hcnt, 1u, __ATOMIC_RELAXED, __HIP_MEMORY_SCOPE_WORKGROUP); \
    htarget += 4u; \
    while ((unsigned)__builtin_amdgcn_readfirstlane((int)__hip_atomic_load((LAS unsigned*)hcnt, __ATOMIC_RELAXED, __HIP_MEMORY_SCOPE_WORKGROUP)) < htarget) __builtin_amdgcn_s_sleep(1); \
    __builtin_amdgcn_s_sleep(4); asm volatile("s_waitcnt vmcnt(0) lgkmcnt(0)" ::: "memory"); } while (0)
    const char* kp[NS][2]; const char* vp[2];
#pragma unroll
    for (int sidx = 0; sidx < NS; ++sidx)
#pragma unroll
        for (int e = 0; e < 2; ++e) kp[sidx][e] = K_lds + k8_addr<DQK>(r32, 4 * sidx + 2 * hi + e);
#pragma unroll
    for (int e = 0; e < 2; ++e) vp[e] = V_lds + vt_addr(r32, 2 * hi + e);
    const int NT = seq / KSTEP;
    if (tl == 0) *hcnt = 0u;
    __syncthreads();
    DMA8(0, 0); HBAR();
#define F8_SUB(BUF, T2) do { \
        f32x16 p0 = {}, p1 = {}; \
        _Pragma("unroll") for (int sidx = 0; sidx < NS; ++sidx) { \
            const i32x4 a0 = *reinterpret_cast<const i32x4*>(kp[sidx][0] + (BUF) * SHM_K8 + (2 * (T2)) * 32 * KROW), a1 = *reinterpret_cast<const i32x4*>(kp[sidx][1] + (BUF) * SHM_K8 + (2 * (T2)) * 32 * KROW); \
            const i32x4 b0 = *reinterpret_cast<const i32x4*>(kp[sidx][0] + (BUF) * SHM_K8 + (2 * (T2) + 1) * 32 * KROW), b1 = *reinterpret_cast<const i32x4*>(kp[sidx][1] + (BUF) * SHM_K8 + (2 * (T2) + 1) * 32 * KROW); \
            p0 = __builtin_amdgcn_mfma_scale_f32_32x32x64_f8f6f4(__builtin_shufflevector(a0, a1, 0, 1, 2, 3, 4, 5, 6, 7), qf[sidx], p0, 0, 0, 0, 0x7f7f7f7f, 0, 0x7f7f7f7f); \
            p1 = __builtin_amdgcn_mfma_scale_f32_32x32x64_f8f6f4(__builtin_shufflevector(b0, b1, 0, 1, 2, 3, 4, 5, 6, 7), qf[sidx], p1, 0, 0, 0, 0x7f7f7f7f, 0, 0x7f7f7f7f); } \
        float pm0 = __builtin_amdgcn_fmed3f(p0[0], p0[1], __builtin_inff()), pm1 = __builtin_amdgcn_fmed3f(p1[0], p1[1], __builtin_inff());     \
        _Pragma("unroll") for (int r = 2; r < 16; ++r) { pm0 = __builtin_amdgcn_fmed3f(pm0, p0[r], __builtin_inff()); pm1 = __builtin_amdgcn_fmed3f(pm1, p1[r], __builtin_inff()); } \
        float pmax = __builtin_amdgcn_fmed3f(pm0, pm1, __builtin_inff()); \
        { auto rr = __builtin_amdgcn_permlane32_swap(__float_as_uint(pmax), __float_as_uint(pmax), false, false); pmax = fmaxf(__uint_as_float(rr[0]), __uint_as_float(rr[1])); } \
        float alpha = 1.f; \
        if (!__builtin_expect(__all(pmax - m_reg <= THR / SCALE), 1)) { const float mn = fmaxf(m_reg, pmax); alpha = __builtin_amdgcn_exp2f((m_reg - mn) * C); m_reg = mn; } \
        const float mnC = 6.f - m_reg * C; \
        float ps = 0.f; \
        _Pragma("unroll") for (int r = 0; r < 16; ++r) { p0[r] = __builtin_amdgcn_exp2f(fmaf(p0[r], C, mnC)); p1[r] = __builtin_amdgcn_exp2f(fmaf(p1[r], C, mnC)); ps += p0[r] + p1[r]; } \
        l_reg = l_reg * alpha + half_sum(ps); \
        i32x8 pf; \
        _Pragma("unroll") for (int v = 0; v < 4; ++v) { pf[v] = (int)f2f8x4(p0[4 * v], p0[4 * v + 1], p0[4 * v + 2], p0[4 * v + 3]); pf[4 + v] = (int)f2f8x4(p1[4 * v], p1[4 * v + 1], p1[4 * v + 2], p1[4 * v + 3]); } \
        if (__any(alpha < 1.f)) { if (hi == 0) al_l[r32] = alpha; asm volatile("s_waitcnt lgkmcnt(0)" ::: "memory"); \
            _Pragma("unroll") for (int d = 0; d < 4; ++d) _Pragma("unroll") for (int r = 0; r < 16; ++r) o[d][r] *= al_l[crow(r, hi)]; } \
        _Pragma("unroll") for (int d0 = 0; d0 < 4; ++d0) { \
            const i32x4 v0 = *reinterpret_cast<const i32x4*>(vp[0] + (BUF) * SHM_VT + (T2) * 8192 + d0 * 2048), v1 = *reinterpret_cast<const i32x4*>(vp[1] + (BUF) * SHM_VT + (T2) * 8192 + d0 * 2048); \
            o[d0] = __builtin_amdgcn_mfma_scale_f32_32x32x64_f8f6f4(pf, __builtin_shufflevector(v0, v1, 0, 1, 2, 3, 4, 5, 6, 7), o[d0], 0, 0, 0, 0x7f7f7f7f, 0, 0x7f7f7f7f); } \
    } while (0)
#define F8_TILE(BUF, J) do { \
        if ((J) + 1 < NT) DMA8((BUF) ^ 1, ((J) + 1) * KSTEP);        \
        F8_SUB(BUF, 0); if constexpr (NSUB == 2) { __builtin_amdgcn_sched_barrier(0); F8_SUB(BUF, 1); } \
        HBAR(); \
    } while (0)
#pragma unroll 1
    for (int j = 0; j < NT; j += 2) { F8_TILE(0, j); F8_TILE(1, j + 1); }
    unsigned char* Ow = Ob + (long)(wid * 32) * ldo;
    if (hi == 0) al_l[r32] = l_reg; asm volatile("s_waitcnt lgkmcnt(0)" ::: "memory");
#pragma unroll
    for (int r = 0; r < 16; ++r) { const int orow = crow(r, hi); const float rl = 32.f * __builtin_amdgcn_rcpf(al_l[orow]);
#pragma unroll
        for (int d0 = 0; d0 < 4; ++d0) Ow[(long)orow * ldo + d0 * 32 + r32] = f2f8(o[d0][r] * rl); }
    __syncthreads();
#undef DMA8
#undef HBAR
#undef F8_TILE
#undef F8_SUB
}

__device__ __forceinline__ void adaln_unit(CP p, int u, char* lds) {
    const int l = u / 192, cb = u % 192, tid = otid(), kc = tid >> 4, cq = tid & 15;
    const float* W = p->in[4] + (size_t)l * 2048 * 12288 + cb * 64 + cq * 4;
    const float* c = p->in[1]; const float* cc = p->in[3];
    f32x4 a0 = {0, 0, 0, 0}, a1 = a0, a2 = a0;
#pragma unroll 4
    for (int kk = 0; kk < 64; ++kk) {
        const int k = kc * 64 + kk;
        const f32x4 w = *reinterpret_cast<const f32x4*>(W + (size_t)k * 12288);
        const float s0 = silu_f(c[k]), s1 = silu_f(c[2048 + k]), s2 = silu_f(cc[k]);
        a0 += w * s0; a1 += w * s1; a2 += w * s2;
    }
    float* red = (float*)lds;
    float* r = red + (kc * 16 + cq) * 12;
#pragma unroll
    for (int j = 0; j < 4; ++j) { r[j] = a0[j]; r[4 + j] = a1[j]; r[8 + j] = a2[j]; }
    __syncthreads();
    if (tid < 192) {
        const int q = tid / 12, e = tid % 12, row = e >> 2, j = e & 3;
        float s = 0.f;
        for (int k2 = 0; k2 < 32; ++k2) s += red[(k2 * 16 + q) * 12 + e];
        const int col = cb * 64 + q * 4 + j;
        float* MOD = (float*)(p->ws + WS_MOD);
        MOD[((size_t)l * 3 + row) * 12288 + col] = s + p->in[5][(size_t)l * 12288 + col];
    }
    __syncthreads();
}

__device__ __forceinline__ void cvt_tile(const float* __restrict__ src, int ldsrc, int k0, int n0, bf16_t* __restrict__ dst, int drow0, int ldd, const float* __restrict__ kscale, char* lds) {
    float* tile = (float*)lds;
    const int tid = otid();
#pragma unroll
    for (int it = 0; it < 2; ++it) {
        const int kk = (tid >> 4) + 32 * it, nq = (tid & 15) * 4;
        f32x4 v = *reinterpret_cast<const f32x4*>(src + (size_t)(k0 + kk) * ldsrc + n0 + nq);
        if (kscale) v *= kscale[k0 + kk];
        tile[kk * 65 + nq + 0] = v[0]; tile[kk * 65 + nq + 1] = v[1]; tile[kk * 65 + nq + 2] = v[2]; tile[kk * 65 + nq + 3] = v[3];
    }
    __syncthreads();
    { const int n = tid >> 3, kq = (tid & 7) * 8;
      u32x4 w;
#pragma unroll
      for (int i = 0; i < 4; ++i) w[i] = cvtpk(tile[(kq + 2 * i) * 65 + n], tile[(kq + 2 * i + 1) * 65 + n]);
      *reinterpret_cast<u32x4*>(dst + (size_t)(drow0 + n) * ldd + k0 + kq) = w; }
    __syncthreads();
}

__device__ __forceinline__ void cvt_tile_f8(const float* __restrict__ src, int ldsrc, int k0, int n0, unsigned char* __restrict__ dst, int drow0, int ldd, float scale, char* lds) {
    float* tile = (float*)lds;
    const int tid = otid();
#pragma unroll
    for (int it = 0; it < 2; ++it) {
        const int kk = (tid >> 4) + 32 * it, nq = (tid & 15) * 4;
        const f32x4 v = *reinterpret_cast<const f32x4*>(src + (size_t)(k0 + kk) * ldsrc + n0 + nq) * scale;
        tile[kk * 65 + nq + 0] = v[0]; tile[kk * 65 + nq + 1] = v[1]; tile[kk * 65 + nq + 2] = v[2]; tile[kk * 65 + nq + 3] = v[3];
    }
    __syncthreads();
    { const int n = tid >> 3, kq = (tid & 7) * 8;
      u32x2 w = {f2f8x4(tile[(kq + 0) * 65 + n], tile[(kq + 1) * 65 + n], tile[(kq + 2) * 65 + n], tile[(kq + 3) * 65 + n]),
                 f2f8x4(tile[(kq + 4) * 65 + n], tile[(kq + 5) * 65 + n], tile[(kq + 6) * 65 + n], tile[(kq + 7) * 65 + n])};
      *reinterpret_cast<u32x2*>(dst + (size_t)(drow0 + n) * ldd + k0 + kq) = w; }
    __syncthreads();
}

__device__ __forceinline__ void cvt_tile_f8w(const float* __restrict__ src, int ldsrc, int k0, int n0, unsigned char* __restrict__ dst, int drow0, int ldd, float scale, char* lds) {
    float* tile = (float*)lds;
    const int tid = otid();
#pragma unroll
    for (int it = 0; it < 4; ++it) {
        const int kk = (tid >> 4) + 32 * it, nq = (tid & 15) * 4;
        const f32x4 v = *reinterpret_cast<const f32x4*>(src + (size_t)(k0 + kk) * ldsrc + n0 + nq) * scale;
        tile[kk * 65 + nq + 0] = v[0]; tile[kk * 65 + nq + 1] = v[1]; tile[kk * 65 + nq + 2] = v[2]; tile[kk * 65 + nq + 3] = v[3];
    }
    __syncthreads();
    { const int n = tid >> 3, kq = (tid & 7) * 16;
      u32x4 w;
#pragma unroll
      for (int e = 0; e < 4; ++e) w[e] = f2f8x4(tile[(kq + 4 * e) * 65 + n], tile[(kq + 4 * e + 1) * 65 + n], tile[(kq + 4 * e + 2) * 65 + n], tile[(kq + 4 * e + 3) * 65 + n]);
      *reinterpret_cast<u32x4*>(dst + (size_t)(drow0 + n) * ldd + k0 + kq) = w; }
    __syncthreads();
}

__device__ __forceinline__ void fold_unit(CP p, int u, char* lds) {
    const int l = u >> 6, g = (u >> 4) & 3, kp = u & 15, tid = otid();
    float* T = (float*)lds;
    float* wt = T + 128 * 128;
    for (int i = tid; i < 128 * 128; i += NTHREADS) {
        const int c = i >> 7, j = i & 127, m = j >> 1;
        float v;
        if (j == 0) v = 1.f; else if (j == 1) v = (c & 1) ? -1.f : 1.f;
        else { const float x = (float)((m * c) & 127) / 64.f; v = (j & 1) ? -sinpif(x) : cospif(x); }
        T[i] = v * 0.088388347648318440f;
    }
    const float* W = p->in[8] + (size_t)l * 2048 * INC + OFF_D + g * 128;
    for (int kt = 2 * kp; kt < 2 * kp + 2; ++kt) {
    for (int i = tid; i < 64 * 32; i += NTHREADS) {
        const int kk = i >> 5, cq = (i & 31) * 4;
        const f32x4 v = *reinterpret_cast<const f32x4*>(W + (size_t)(kt * 64 + kk) * INC + cq);
        wt[kk * 129 + cq] = v[0]; wt[kk * 129 + cq + 1] = v[1]; wt[kk * 129 + cq + 2] = v[2]; wt[kk * 129 + cq + 3] = v[3];
    }
    __syncthreads();
    unsigned char* Bt = (unsigned char*)(p->ws + WS_BTIN) + (size_t)l * INCP * 2048;
    const int k = tid & 63, jb = tid >> 6;
    float acc[16];
#pragma unroll
    for (int i = 0; i < 16; ++i) acc[i] = 0.f;
#pragma unroll 4
    for (int c = 0; c < 128; ++c) {
        const float w = wt[k * 129 + c]; const f32x4* Tr = reinterpret_cast<const f32x4*>(T + c * 128 + jb * 16);
#pragma unroll
        for (int q = 0; q < 4; ++q) { const f32x4 t = Tr[q]; acc[4 * q] += w * t[0]; acc[4 * q + 1] += w * t[1]; acc[4 * q + 2] += w * t[2]; acc[4 * q + 3] += w * t[3]; }
    }
#pragma unroll
    for (int i = 0; i < 16; ++i) Bt[(size_t)(OFF_D + g * 128 + jb * 16 + i) * 2048 + kt * 64 + k] = f2f8(acc[i] * 64.f);
    __syncthreads();
    }
}

__device__ __forceinline__ void s5_tables(CP p, int idx) {
    const int pp = idx & 63, g = (idx >> 6) & 31, dir = (idx >> 11) & 1, l = idx >> 12;
    const size_t ldg = ((size_t)l * 2 + dir) * 32 + g;
    const float lr = p->in[15][ldg * 64 + pp], li = p->in[16][ldg * 64 + pp], dt = expf(p->in[17][ldg]);
    const float er = expf(lr * dt); float sn, cs; sincosf(li * dt, &sn, &cs);
    const float br_ = er * cs, bi_ = er * sn;
    float Lr = br_, Li = bi_;
#pragma unroll
    for (int s = 0; s < 6; ++s) { const float nr = Lr * Lr - Li * Li, ni = 2.f * Lr * Li; Lr = nr; Li = ni; }
    float* LAM = (float*)(p->ws + WS_S5LAM) + (ldg * 64 + pp) * 4;
    LAM[0] = br_; LAM[1] = bi_; LAM[2] = Lr; LAM[3] = Li;
    const float nr = br_ - 1.f, ni = bi_, den = lr * lr + li * li;
    const float fr = (nr * lr + ni * li) / den, fi = (ni * lr - nr * li) / den;
    bf16_t* BM = (bf16_t*)(p->ws + WS_S5BM) + ldg * 128 * 16;
    const float* Bre = p->in[18] + (ldg * 64 + pp) * 16; const float* Bim = p->in[19] + (ldg * 64 + pp) * 16;
    for (int h = 0; h < 16; ++h) {
        const float xr = Bre[h], xi = Bim[h];
        BM[(size_t)pp * 16 + h] = f2bf(fr * xr - fi * xi);
        BM[(size_t)(64 + pp) * 16 + h] = f2bf(fr * xi + fi * xr);
    }
    bf16_t* CM = (bf16_t*)(p->ws + WS_S5CM) + ((size_t)l * 32 + g) * 16 * 256;
    const float* Cre = p->in[20] + ldg * 16 * 64; const float* Cim = p->in[21] + ldg * 16 * 64;
    for (int h = 0; h < 16; ++h) {
        CM[(size_t)h * 256 + dir * 128 + 2 * pp] = f2bf(Cre[h * 64 + pp]);
        CM[(size_t)h * 256 + dir * 128 + 2 * pp + 1] = f2bf(-Cim[h * 64 + pp]);
    }
}

__device__ __forceinline__ void prologue(CP p, char* lds) {
    const int G = gridDim.x, bid = obid(), tid = otid();
    { const int idx = bid * NTHREADS + tid;
      if (idx < 8192) { float2* TW = (float2*)(p->ws + WS_TW); const float x = (float)idx / 8192.f; TW[idx] = make_float2(cospif(x), -sinpif(x)); }
      for (int i = idx; i < 8192; i += G * NTHREADS) s5_tables(p, i); }
    for (int u = bid; u < 384; u += G) adaln_unit(p, u, lds);
    for (int u = bid; u < 128; u += G) fold_unit(p, u, lds);
    for (int l = 0; l < 2; ++l) {
        { const float* src = p->in[8] + (size_t)l * 2048 * INC; unsigned char* dst = (unsigned char*)(p->ws + WS_BTIN) + (size_t)l * INCP * 2048;
          for (int u = bid; u < 16 * 33; u += G) { const int kp = u / 33, nt = u % 33;
              for (int kt = 2 * kp; kt < 2 * kp + 2; ++kt) cvt_tile_f8(src, INC, kt * 64, nt * 64, dst, nt * 64, 2048, 64.f, lds); } }
        { const float* src = p->in[10] + (size_t)l * 384 * 768; bf16_t* dst = (bf16_t*)(p->ws + WS_BTUQ) + (size_t)l * 768 * 384;
          for (int u = bid; u < 6 * 12; u += G) { const int kt = u / 12, nt = u % 12; cvt_tile(src, 768, kt * 64, nt * 64, dst, nt * 64, 384, p->in[9] + l * 384, lds); } }
        { const float* src = p->in[12] + (size_t)l * 128 * 1024; bf16_t* dst = (bf16_t*)(p->ws + WS_BTUKV) + (size_t)l * 1024 * 256;
          for (int u = bid; u < 2 * 16; u += G) { const int kt = u / 16, nt = u % 16; cvt_tile(src, 1024, kt * 64, nt * 64, dst, nt * 64, 256, p->in[11] + l * 128, lds); }
          for (int i = bid * NTHREADS + tid; i < 1024 * 16; i += G * NTHREADS) { const int n = i >> 4, kq = (i & 15) * 8; *reinterpret_cast<u32x4*>(dst + (size_t)n * 256 + 128 + kq) = (u32x4){0u, 0u, 0u, 0u}; } }
        { const float* src = p->in[23] + (size_t)l * 512 * 1024; bf16_t* dst = (bf16_t*)(p->ws + WS_BTGLU) + (size_t)l * 1024 * 512;
          for (int u = bid; u < 8 * 16; u += G) { const int kt = u / 16, nt = u % 16, n0 = nt * 64;
              const int drow = n0 < 512 ? (n0 >> 7) * 256 + (n0 & 127) : ((n0 - 512) >> 7) * 256 + 128 + (n0 & 127);
              cvt_tile(src, 1024, kt * 64, n0, dst, drow, 512, nullptr, lds); } }
        { const float* src = p->in[24] + (size_t)l * 2048 * 2048; unsigned char* dst = (unsigned char*)(p->ws + WS_BTOUT) + (size_t)l * 2048 * 2048;
          for (int u = bid; u < 16 * 32; u += G) { const int kp = u / 32, nt = u % 32;
              for (int kt = 2 * kp; kt < 2 * kp + 2; ++kt) cvt_tile_f8(src, 2048, kt * 64, nt * 64, dst, nt * 64, 2048, kt < 16 ? 16.f : (kt < 24 ? 512.f : 2048.f), lds); } }
    }
    for (int u = bid; u < 32 * 2 * 256; u += G) {
        const int le = u >> 9, which = (u >> 8) & 1, t = u & 255, kt = t >> 4, nt = t & 15, n0 = nt * 64;
        const float* src = p->in[27 + which] + (size_t)le * 2048 * 1024; unsigned char* dst = (unsigned char*)(p->ws + WS_BTGU) + (size_t)le * 2048 * 2048;
        cvt_tile_f8w(src, 1024, kt * 128, n0, dst, (n0 >> 7) * 256 + which * 128 + (n0 & 127), 2048, 64.f, lds);
    }
    for (int u = bid; u < 32 * 256; u += G) {
        const int le = u >> 8, t = u & 255, kt = t >> 5, nt = t & 31;
        const float* src = p->in[29] + (size_t)le * 1024 * 2048; unsigned char* dst = (unsigned char*)(p->ws + WS_BTDN) + (size_t)le * 2048 * 1024;
        cvt_tile_f8w(src, 2048, kt * 128, nt * 64, dst, nt * 64, 1024, 32.f, lds);
    }
}

struct RowVals { f32x4 v[8]; };
__device__ __forceinline__ void row_load(RowVals& x, const float* __restrict__ src, int lane) {
#pragma unroll
    for (int i = 0; i < 8; ++i) x.v[i] = *reinterpret_cast<const f32x4*>(src + lane * 4 + 256 * i);
}
__device__ __forceinline__ float row_rstd(const RowVals& x) {
    float s = 0.f;
#pragma unroll
    for (int i = 0; i < 8; ++i) s += x.v[i][0] * x.v[i][0] + x.v[i][1] * x.v[i][1] + x.v[i][2] * x.v[i][2] + x.v[i][3] * x.v[i][3];
    s = wave_sum(s);
    return rsqrtf(s * (1.f / 2048.f) + RMS_EPS);
}
__device__ __forceinline__ void row_modulate_store_f8(RowVals& x, float rstd, const float* __restrict__ g, const float* __restrict__ sh, const float* __restrict__ sc, unsigned char* __restrict__ dst, int lane) {
#pragma unroll
    for (int i = 0; i < 8; ++i) {
        const int c = lane * 4 + 256 * i;
        const f32x4 gg = *reinterpret_cast<const f32x4*>(g + c), s1 = *reinterpret_cast<const f32x4*>(sc + c), s0 = *reinterpret_cast<const f32x4*>(sh + c);
        f32x4 h;
#pragma unroll
        for (int j = 0; j < 4; ++j) h[j] = (x.v[i][j] * rstd * gg[j]) * (1.f + s1[j]) + s0[j];
        x.v[i] = h;
        *reinterpret_cast<unsigned*>(dst + c) = f2f8x4(h[0], h[1], h[2], h[3]);
    }
}
__device__ __forceinline__ void row_modulate_store(RowVals& x, float rstd, const float* __restrict__ g, const float* __restrict__ sh, const float* __restrict__ sc, bf16_t* __restrict__ dst, int lane) {
#pragma unroll
    for (int i = 0; i < 8; ++i) {
        const int c = lane * 4 + 256 * i;
        const f32x4 gg = *reinterpret_cast<const f32x4*>(g + c), s1 = *reinterpret_cast<const f32x4*>(sc + c), s0 = *reinterpret_cast<const f32x4*>(sh + c);
        f32x4 h;
#pragma unroll
        for (int j = 0; j < 4; ++j) h[j] = (x.v[i][j] * rstd * gg[j]) * (1.f + s1[j]) + s0[j];
        x.v[i] = h;
        u32x2 w = {cvtpk(h[0], h[1]), cvtpk(h[2], h[3])};
        *reinterpret_cast<u32x2*>(dst + c) = w;
    }
}
__device__ __forceinline__ void row_moe_combine(RowVals& x, const unsigned char* __restrict__ y0, const unsigned char* __restrict__ y1, float gw0, float gw1, const float* __restrict__ g2, int lane) {
    gw0 *= (1.f / 16.f); gw1 *= (1.f / 16.f);
#pragma unroll
    for (int i = 0; i < 8; ++i) {
        const int c = lane * 4 + 256 * i;
        const int a = *reinterpret_cast<const int*>(y0 + c), b = *reinterpret_cast<const int*>(y1 + c);
        const f32x4 gg = *reinterpret_cast<const f32x4*>(g2 + c);
        const f32x2 a01 = __builtin_amdgcn_cvt_pk_f32_fp8(a, false), a23 = __builtin_amdgcn_cvt_pk_f32_fp8(a, true), b01 = __builtin_amdgcn_cvt_pk_f32_fp8(b, false), b23 = __builtin_amdgcn_cvt_pk_f32_fp8(b, true);
        x.v[i][0] += gg[0] * (gw0 * a01[0] + gw1 * b01[0]);
        x.v[i][1] += gg[1] * (gw0 * a01[1] + gw1 * b01[1]);
        x.v[i][2] += gg[2] * (gw0 * a23[0] + gw1 * b23[0]);
        x.v[i][3] += gg[3] * (gw0 * a23[1] + gw1 * b23[1]);
    }
}
__device__ __forceinline__ bf16_t* xres_row(CP p, int row) {
    const int b = row / NTOK, t = row % NTOK;
    return t < CTX ? (bf16_t*)(p->ws + WS_CTXX) + (size_t)(b * CTX + t) * DM : (bf16_t*)(p->out + (size_t)(b * SEQ + t - CTX) * DM + DM / 2);
}
__device__ __forceinline__ void row_load_bf(RowVals& x, const bf16_t* __restrict__ src, int lane) {
#pragma unroll
    for (int i = 0; i < 8; ++i) { const u32x2 w = *reinterpret_cast<const u32x2*>(src + lane * 4 + 256 * i); x.v[i] = (f32x4){bflo(w[0]), bfhi(w[0]), bflo(w[1]), bfhi(w[1])}; }
}
__device__ __forceinline__ void row_store_bf(const RowVals& x, bf16_t* __restrict__ dst, int lane) {
#pragma unroll
    for (int i = 0; i < 8; ++i) { u32x2 w = {cvtpk(x.v[i][0], x.v[i][1]), cvtpk(x.v[i][2], x.v[i][3])}; *reinterpret_cast<u32x2*>(dst + lane * 4 + 256 * i) = w; }
}
__device__ __forceinline__ const float* xin_row(CP p, int row) {
    const int b = row / NTOK, t = row % NTOK;
    return t < CTX ? p->in[2] + (size_t)(b * CTX + t) * DM : p->in[0] + (size_t)(b * SEQ + t - CTX) * DM;
}
__device__ __forceinline__ const float* mod_row(CP p, int l, int row) {
    const int b = row / NTOK, t = row % NTOK;
    return (const float*)(p->ws + WS_MOD) + ((size_t)l * 3 + (t < CTX ? 2 : b)) * 12288;
}

__device__ __forceinline__ void phase_norm1(CP p, int l) {
    const int tid_ = otid(), wid = tid_ >> 6, lane = tid_ & 63;
    bf16_t* HL = (bf16_t*)(p->ws + WS_HL);
    for (int row = obid() * 8 + wid; row < MR; row += gridDim.x * 8) {
        RowVals x;
        if (l == 0) row_load(x, xin_row(p, row), lane);
        else {
            bf16_t* xr = xres_row(p, row); row_load_bf(x, xr, lane);
            const unsigned char* Y = (const unsigned char*)(p->ws + WS_Y) + (size_t)row * 2 * DM; const float* GT = (const float*)(p->ws + WS_GATE) + (size_t)row * 2;
            row_moe_combine(x, Y, Y + DM, GT[0], GT[1], mod_row(p, 0, row) + 5 * 2048, lane);
            row_store_bf(x, xr, lane);
        }
        const float rstd = row_rstd(x); const float* md = mod_row(p, l, row);
        row_modulate_store_f8(x, rstd, p->in[6] + l * DM, md, md + 2048, (unsigned char*)HL + (size_t)row * DM, lane);
    }
}
__device__ __forceinline__ void phase_final(CP p) {
    const int tid_ = otid(), wid = tid_ >> 6, lane = tid_ & 63;
    for (int rr = obid() * 8 + wid; rr < NBATCH * SEQ; rr += gridDim.x * 8) {
        const int b = rr / SEQ, row = b * NTOK + CTX + (rr % SEQ);
#if DBG_STOP && DBG_STOP < 8
        {
            const bf16_t* HL = (const bf16_t*)(p->ws + WS_HL); const bf16_t* PL = (const bf16_t*)(p->ws + WS_PL); const bf16_t* A2 = (const bf16_t*)(p->ws + WS_A2);
            const bf16_t* QM = (const bf16_t*)(p->ws + WS_QM); const bf16_t* KM = (const bf16_t*)(p->ws + WS_KM); const bf16_t* VM = (const bf16_t*)(p->ws + WS_VM);
            const bf16_t* MIX = (const bf16_t*)(p->ws + WS_MIX); const bf16_t* YB = (const bf16_t*)(p->ws + WS_YB);
            const float* S5E = (const float*)(p->ws + WS_S5E); const float* S5H = (const float*)(p->ws + WS_S5H);
            const int rowc = b * NTOK + (rr % SEQ) % CTX;
            for (int c = lane; c < DM; c += 64) {
                float v = 0.f; const size_t flat = ((size_t)rr * DM + c) % 4259840;
                if (DBG_STOP == 2) v = bf2f(HL[(size_t)row * DM + c]) + bf2f(HL[(size_t)rowc * DM + c]);
                if (DBG_STOP == 3) v = bf2f(PL[(size_t)row * INC + c]) + bf2f(PL[(size_t)row * INC + c + 576]) + bf2f(PL[(size_t)rowc * INC + c]);
                if (DBG_STOP == 4) v = (DBG_TAP == 0 ? bf2f(MIX[(size_t)row * DM + 1536 + (c & 511)]) + bf2f(MIX[(size_t)rowc * DM + 1536 + (c & 511)]) : 0.f)
                                     + (DBG_TAP == 1 ? bf2f(A2[(size_t)row * 640 + c % 640]) + bf2f(PL[(size_t)row * INC + c + 576]) + bf2f(KM[(size_t)row * 768 + (c & 3) * 192 + 128 + ((c >> 2) & 63)]) : 0.f)
                                     + (DBG_TAP == 2 ? S5E[flat] : 0.f);
                if (DBG_STOP == 5) v = (DBG_TAP == 0 ? bf2f(QM[(size_t)row * 768 + c % 768]) + bf2f(KM[(size_t)row * 768 + c % 768]) + bf2f(VM[(size_t)row * 512 + (c & 511)]) : 0.f) + (DBG_TAP == 1 ? S5H[flat] : 0.f);
                if (DBG_STOP == 6) v = (DBG_TAP == 0 ? bf2f(MIX[(size_t)row * DM + (c & 511)]) : 0.f) + (DBG_TAP == 1 ? bf2f(MIX[(size_t)row * DM + 512 + (c & 511)]) : 0.f) + (DBG_TAP == 2 ? bf2f(YB[(size_t)row * 512 + (c & 511)]) : 0.f)
                                     + (DBG_TAP == 3 ? bf2f(MIX[(size_t)rowc * DM + (c & 1023)]) + bf2f(YB[(size_t)rowc * 512 + (c & 511)]) : 0.f);
                if (DBG_STOP == 7) v = bf2f(MIX[(size_t)row * DM + 1024 + (c & 511)]) + bf2f(MIX[(size_t)rowc * DM + 1024 + (c & 511)]);
                p->out[(size_t)rr * DM + c] = v;
            }
            continue;
        }
#endif
        RowVals x; float* xr = p->out + (size_t)rr * DM; row_load_bf(x, xres_row(p, row), lane);
        const unsigned char* Y = (const unsigned char*)(p->ws + WS_Y) + (size_t)row * 2 * DM; const float* GT = (const float*)(p->ws + WS_GATE) + (size_t)row * 2;
        if (!DBG_STOP) row_moe_combine(x, Y, Y + DM, GT[0], GT[1], mod_row(p, 1, row) + 5 * 2048, lane);
        const float rstd = row_rstd(x);
#pragma unroll
        for (int i = 0; i < 8; ++i) {
            const int c = lane * 4 + 256 * i; const f32x4 gg = *reinterpret_cast<const f32x4*>(p->in[30] + c);
            f32x4 o; for (int j = 0; j < 4; ++j) o[j] = x.v[i][j] * rstd * gg[j];
            *reinterpret_cast<f32x4*>(xr + c) = o;
        }
    }
}
struct RouteSel { int e1, e2; float g1, g2; };
__device__ __forceinline__ RouteSel route_select(const float (&lg)[16], const float (&bias)[16]) {
    float sc[16], sel[16];
#pragma unroll
    for (int e = 0; e < 16; ++e) { sc[e] = sigmoid_f(lg[e]); sel[e] = sc[e] + bias[e]; }
    int grp = 0; float best = -1e30f;
#pragma unroll
    for (int g = 0; g < 4; ++g) {
        const float a = sel[4 * g], b = sel[4 * g + 1], c = sel[4 * g + 2], d = sel[4 * g + 3];
        const float m1 = fmaxf(fmaxf(a, b), fmaxf(c, d));
        const float hi1 = fmaxf(a, b), lo1 = fminf(a, b), hi2 = fmaxf(c, d), lo2 = fminf(c, d);
        const float m2 = fmaxf(fminf(hi1, hi2), fmaxf(lo1, lo2));
        const float gs = m1 + m2;
        if (gs > best) { best = gs; grp = g; }
    }
    float s4[4], c4[4];
#pragma unroll
    for (int i = 0; i < 4; ++i) { s4[i] = 0.f; c4[i] = 0.f; }
#pragma unroll
    for (int g = 0; g < 4; ++g)
#pragma unroll
        for (int i = 0; i < 4; ++i) if (g == grp) { s4[i] = sel[4 * g + i]; c4[i] = sc[4 * g + i]; }
    int i1 = 0; float v1 = s4[0];
#pragma unroll
    for (int i = 1; i < 4; ++i) if (s4[i] > v1) { v1 = s4[i]; i1 = i; }
    int i2 = -1; float v2 = -1e30f;
#pragma unroll
    for (int i = 0; i < 4; ++i) if (i != i1 && s4[i] > v2) { v2 = s4[i]; i2 = i; }
    float g1v = 0.f, g2v = 0.f;
#pragma unroll
    for (int i = 0; i < 4; ++i) { if (i == i1) g1v = c4[i]; if (i == i2) g2v = c4[i]; }
    const float inv = 1.f / (g1v + g2v);
    RouteSel r; r.e1 = grp * 4 + i1; r.e2 = grp * 4 + i2; r.g1 = g1v * inv; r.g2 = g2v * inv; return r;
}
__device__ __forceinline__ void phase_norm2(CP p, int l, char* lds) {
    const int tid = otid(), wid = tid >> 6, lane = tid & 63;
    float* rwT = (float*)lds;
    for (int i = tid; i < 2048 * 16; i += NTHREADS) rwT[(i & 15) * 2052 + (i >> 4)] = p->in[25][i];
    LAS unsigned* lcnt = (LAS unsigned*)(lds + 131584);
    LAS unsigned* lbase = (LAS unsigned*)(lds + 131584 + 64);
    LAS unsigned* route = (LAS unsigned*)(lds + 131584 + 128) + wid * 64;
    if (tid < 16) lcnt[tid] = 0u;
    __syncthreads();
    unsigned char* HL8 = (unsigned char*)(p->ws + WS_HL);
    unsigned* CNT = (unsigned*)(p->ws + WS_CTL) + CW_CNT + l * 16 * 16;
    int* LIST = (int*)(p->ws + WS_LIST); float* GT = (float*)(p->ws + WS_GATE);
    float bias[16];
#pragma unroll
    for (int e = 0; e < 16; ++e) bias[e] = p->in[26][e];
    const int stride = gridDim.x * 8, first = obid() * 8 + wid;
    int it = 0;
    for (int row = first; row < MR; row += 2 * stride, it += 2) {
        const int rowb = row + stride;
        const bool va = !(l == 1 && (row % NTOK) < CTX), vb = rowb < MR && !(l == 1 && (rowb % NTOK) < CTX);
        RowVals xa, xb;
        if (va) { row_load_bf(xa, xres_row(p, row), lane); const float rstd = row_rstd(xa); const float* md = mod_row(p, l, row);
                  row_modulate_store_f8(xa, rstd, p->in[7] + l * DM, md + 3 * 2048, md + 4 * 2048, HL8 + (size_t)row * DM, lane); }
        else {
#pragma unroll
            for (int i = 0; i < 8; ++i) xa.v[i] = (f32x4){0.f, 0.f, 0.f, 0.f}; }
        if (vb) { row_load_bf(xb, xres_row(p, rowb), lane); const float rstd = row_rstd(xb); const float* md = mod_row(p, l, rowb);
                  row_modulate_store_f8(xb, rstd, p->in[7] + l * DM, md + 3 * 2048, md + 4 * 2048, HL8 + (size_t)rowb * DM, lane); }
        else {
#pragma unroll
            for (int i = 0; i < 8; ++i) xb.v[i] = (f32x4){0.f, 0.f, 0.f, 0.f}; }
        float lga[16], lgb[16];
#pragma unroll
        for (int e = 0; e < 16; ++e) {
            float sa = 0.f, sb = 0.f;
#pragma unroll
            for (int i = 0; i < 8; ++i) { const f32x4 w = *reinterpret_cast<const f32x4*>(rwT + e * 2052 + lane * 4 + 256 * i);
                sa += xa.v[i][0] * w[0] + xa.v[i][1] * w[1] + xa.v[i][2] * w[2] + xa.v[i][3] * w[3];
                sb += xb.v[i][0] * w[0] + xb.v[i][1] * w[1] + xb.v[i][2] * w[2] + xb.v[i][3] * w[3]; }
            lga[e] = sa; lgb[e] = sb;
        }
#pragma unroll
        for (int e = 0; e < 16; ++e) { lga[e] = wave_sum(lga[e]); lgb[e] = wave_sum(lgb[e]); }
        const RouteSel ra = route_select(lga, bias), rb = route_select(lgb, bias);
        if (lane == 0) {
            if (va) { const unsigned p1 = __hip_atomic_fetch_add(lcnt + ra.e1, 1u, __ATOMIC_RELAXED, __HIP_MEMORY_SCOPE_WORKGROUP), p2 = __hip_atomic_fetch_add(lcnt + ra.e2, 1u, __ATOMIC_RELAXED, __HIP_MEMORY_SCOPE_WORKGROUP);
                      route[it * 2] = (unsigned)ra.e1 | (p1 << 8); route[it * 2 + 1] = (unsigned)ra.e2 | (p2 << 8); st_wt(GT + (size_t)row * 2, ra.g1); st_wt(GT + (size_t)row * 2 + 1, ra.g2); }
            else route[it * 2] = 0xffffffffu;
            if (vb) { const unsigned p1 = __hip_atomic_fetch_add(lcnt + rb.e1, 1u, __ATOMIC_RELAXED, __HIP_MEMORY_SCOPE_WORKGROUP), p2 = __hip_atomic_fetch_add(lcnt + rb.e2, 1u, __ATOMIC_RELAXED, __HIP_MEMORY_SCOPE_WORKGROUP);
                      route[it * 2 + 2] = (unsigned)rb.e1 | (p1 << 8); route[it * 2 + 3] = (unsigned)rb.e2 | (p2 << 8); st_wt(GT + (size_t)rowb * 2, rb.g1); st_wt(GT + (size_t)rowb * 2 + 1, rb.g2); }
            else route[it * 2 + 2] = 0xffffffffu;
        }
    }
    __syncthreads();
    if (tid < 16) lbase[tid] = atomicAdd(&CNT[tid * 16], lcnt[tid]);
    __syncthreads();
    if (lane < it) {
        const int row = first + lane * stride; const unsigned r1 = route[lane * 2];
        if (r1 != 0xffffffffu) { const unsigned r2 = route[lane * 2 + 1];
            st_wt(LIST + (size_t)(r1 & 255u) * MR + lbase[r1 & 255u] + (r1 >> 8), row * 2);
            st_wt(LIST + (size_t)(r2 & 255u) * MR + lbase[r2 & 255u] + (r2 >> 8), row * 2 + 1); }
    }
    __syncthreads();
}

__device__ __forceinline__ void phase_post(CP p, int l) {
    const int tid_ = otid(), wid = tid_ >> 6, lane = tid_ & 63;
    bf16_t* PL = (bf16_t*)(p->ws + WS_PL); bf16_t* A2 = (bf16_t*)(p->ws + WS_A2); unsigned char* K8M = (unsigned char*)(p->ws + WS_K8M); unsigned char* K8G = (unsigned char*)(p->ws + WS_K8G);
    const float gq0 = p->in[13][l * 128 + lane], gq1 = p->in[13][l * 128 + 64 + lane], gk0 = p->in[14][l * 128 + lane], gk1 = p->in[14][l * 128 + 64 + lane];
    const float invm = __builtin_amdgcn_exp2f(-(float)(lane & 15) * (13.287712379549449f / 16.f) - 2.651496129472319f), invg = __builtin_amdgcn_exp2f(-(float)(lane & 31) * (13.287712379549449f / 32.f) - 2.651496129472319f);
    for (int row = obid() * 8 + wid; row < MR; row += gridDim.x * 8) {
        const int t = row % NTOK; const bool lat = t >= CTX; const int s = t - CTX;
        const float rp = (float)(s >> 6), cp = (float)(s & 63);
        bf16_t* pr = PL + (size_t)row * INC;
        float ql[6], kv[2], kr, hq[6][2];
#pragma unroll
        for (int i = 0; i < 6; ++i) ql[i] = bf2f(pr[lane + 64 * i]);
#pragma unroll
        for (int i = 0; i < 2; ++i) kv[i] = bf2f(pr[384 + lane + 64 * i]);
        kr = bf2f(pr[512 + lane]);
#pragma unroll
        for (int h = 0; h < 6; ++h) { hq[h][0] = bf2f(pr[OFF_B + h * 128 + lane]); hq[h][1] = bf2f(pr[OFF_B + h * 128 + 64 + lane]); }
        float ss[8];
        ss[0] = 0.f;
#pragma unroll
        for (int i = 0; i < 6; ++i) ss[0] += ql[i] * ql[i];
        ss[1] = kv[0] * kv[0] + kv[1] * kv[1];
#pragma unroll
        for (int h = 0; h < 6; ++h) ss[2 + h] = hq[h][0] * hq[h][0] + hq[h][1] * hq[h][1];
#pragma unroll
        for (int e = 0; e < 8; ++e) ss[e] = wave_sum(ss[e]);
        const float rq = rsqrtf(ss[0] * (1.f / 384.f) + RMS_EPS), rk = rsqrtf(ss[1] * (1.f / 128.f) + RMS_EPS);
        bf16_t* a2 = A2 + (size_t)row * 640;
#pragma unroll
        for (int i = 0; i < 6; ++i) a2[lane + 64 * i] = f2bf(ql[i] * rq);
#pragma unroll
        for (int i = 0; i < 2; ++i) a2[384 + lane + 64 * i] = f2bf(kv[i] * rk);
        a2[512 + lane] = 0; a2[576 + lane] = 0;
        { float o = kr;
          if (lat) { const float other = half_other(kr, lane < 32); const float rev = ((lane & 31) < 16 ? rp : cp) * invm; const float sn = __builtin_amdgcn_sinf(rev), cs = __builtin_amdgcn_cosf(rev);
              o = lane < 32 ? kr * cs - other * sn : kr * cs + other * sn; }
          const unsigned char ob = f2f8(o); unsigned char* km = K8M + (size_t)row * 768 + 128 + lane;
          km[0] = ob; km[192] = ob; km[384] = ob; km[576] = ob; }
        float sn = 0.f, cs = 1.f;
        if (lat) { const float rev = (lane < 32 ? rp : cp) * invg; sn = __builtin_amdgcn_sinf(rev); cs = __builtin_amdgcn_cosf(rev); }
#pragma unroll
        for (int h = 0; h < 6; ++h) {
            const float r = rsqrtf(ss[2 + h] * (1.f / 128.f) + RMS_EPS);
            const float n1 = hq[h][0] * r * (h < 4 ? gq0 : gk0), n2 = hq[h][1] * r * (h < 4 ? gq1 : gk1);
            const float o1 = n1 * cs - n2 * sn, o2 = n2 * cs + n1 * sn;
#if PROBE_DRY == 3
            if (h < 4 && p->dry) { bf16_t* pw = (bf16_t*)(p->ws + WS_QM) + (size_t)row * INC; pw[OFF_B + h * 128 + lane] = f2bf(o1); pw[OFF_B + h * 128 + 64 + lane] = f2bf(o2); } else
#endif
            if (h < 4) { pr[OFF_B + h * 128 + lane] = f2bf(o1); pr[OFF_B + h * 128 + 64 + lane] = f2bf(o2); }
            else { unsigned char* kg = K8G + (size_t)row * 256 + (h - 4) * 128 + lane; kg[0] = f2f8(o1); kg[64] = f2f8(o2); }
        }
    }
}

constexpr int S5_RS = 272;
__device__ __forceinline__ int s5_scan_chunk(int dir, int tchunk) {
    if (dir == 0) return tchunk;
    return tchunk < 4 ? 3 - tchunk : 263 - tchunk;
}
__device__ __forceinline__ int s5_unit_group(int u) { const int g5 = u & 31; return (g5 >> 3) | ((g5 & 7) << 2); }
__device__ __forceinline__ bf16x8 ld16_wt(const bf16_t* ptr) {
    const unsigned long long* q8 = reinterpret_cast<const unsigned long long*>(ptr);
    union { unsigned long long q[2]; bf16x8 v; } cv; cv.q[0] = __hip_atomic_load(q8, __ATOMIC_RELAXED, __HIP_MEMORY_SCOPE_AGENT); cv.q[1] = __hip_atomic_load(q8 + 1, __ATOMIC_RELAXED, __HIP_MEMORY_SCOPE_AGENT); return cv.v;
}
template <int MODE>
__device__ __forceinline__ void phase_s5(CP p, int l, char* lds) {
    const int tid = otid(), w = tid >> 6, lane = tid & 63, dir = w >> 2, ch = w & 3, r32 = lane & 31, hi = lane >> 5, fr = lane & 15, fq = lane >> 4;
    const int G = gridDim.x;
    const bf16_t* PL = (const bf16_t*)(p->ws + WS_PL);
    char* myl = lds + w * (64 * S5_RS);
    int cur_bg = -1;
    bf16x8 bfr[4], cfr[8]; float lr = 0.f, li = 0.f, dpar = 0.f;
    bf16x8 afrN[2]; float h0rN = 0.f, h0iN = 0.f; bf16_t uvN[8];
#define S5_LOADS(U_) do { const int b_ = ((U_) & 63) >> 5, g_ = s5_unit_group(U_), tc4_ = (U_) >> 6, tch_ = tc4_ * 4 + ch, row0_ = b_ * NTOK + tch_ * 64; \
      \
    _Pragma("unroll") for (int mb = 0; mb < 2; ++mb) { const unsigned long long* q8_ = reinterpret_cast<const unsigned long long*>(PL + (size_t)(row0_ + mb * 32 + r32) * INC + OFF_C + g_ * 16 + hi * 8); \
        union { unsigned long long q[2]; bf16x8 v; } cv_; cv_.q[0] = __hip_atomic_load(q8_, __ATOMIC_RELAXED, __HIP_MEMORY_SCOPE_AGENT); cv_.q[1] = __hip_atomic_load(q8_ + 1, __ATOMIC_RELAXED, __HIP_MEMORY_SCOPE_AGENT); afrN[mb] = cv_.v; } \
    if (MODE == 1) { const size_t sb_ = ((((size_t)b_ * 2 + dir) * 32 + g_) * NCHUNK + s5_scan_chunk(dir, tch_)) * 128; const float* H0 = (const float*)(p->ws + WS_S5H) + sb_; h0rN = __hip_atomic_load(H0 + lane, __ATOMIC_RELAXED, __HIP_MEMORY_SCOPE_AGENT); h0iN = __hip_atomic_load(H0 + 64 + lane, __ATOMIC_RELAXED, __HIP_MEMORY_SCOPE_AGENT); \
        _Pragma("unroll") for (int q_ = 0; q_ < 8; ++q_) uvN[q_] = __hip_atomic_load(PL + (size_t)(b_ * NTOK + tc4_ * 256 + w * 32 + (q_ >> 2) * 16 + fq * 4 + (q_ & 3)) * INC + OFF_C + g_ * 16 + fr, __ATOMIC_RELAXED, __HIP_MEMORY_SCOPE_AGENT); } } while (0)
    int u = obid();
    if (u < 4160) S5_LOADS(u);
    for (; u < 4160; u += G) {
        const int bg = u & 63, b = bg >> 5, g = s5_unit_group(u), tc4 = u >> 6, tchunk = tc4 * 4 + ch;
        const size_t ldg = ((size_t)l * 2 + dir) * 32 + g;
        if (bg != cur_bg) {
            cur_bg = bg;
            const bf16_t* BM = (const bf16_t*)(p->ws + WS_S5BM) + ldg * 128 * 16;
#pragma unroll
            for (int nb = 0; nb < 4; ++nb) bfr[nb] = ld16_wt(BM + (size_t)(nb * 32 + r32) * 16 + hi * 8);
            const float* LAM = (const float*)(p->ws + WS_S5LAM) + (ldg * 64 + lane) * 4;
            lr = __hip_atomic_load(LAM, __ATOMIC_RELAXED, __HIP_MEMORY_SCOPE_AGENT); li = __hip_atomic_load(LAM + 1, __ATOMIC_RELAXED, __HIP_MEMORY_SCOPE_AGENT);
            if (MODE == 1) {
                const bf16_t* CM = (const bf16_t*)(p->ws + WS_S5CM) + ((size_t)l * 32 + g) * 16 * 256;
#pragma unroll
                for (int ks = 0; ks < 8; ++ks) cfr[ks] = ld16_wt(CM + (size_t)fr * 256 + ks * 32 + fq * 8);
                dpar = p->in[22][l * 512 + g * 16 + fr];
            }
        }
        bf16x8 afr[2] = {afrN[0], afrN[1]}; float hr = h0rN, hi_ = h0iN; bf16_t uv[8];
#pragma unroll
        for (int q_ = 0; q_ < 8; ++q_) uv[q_] = uvN[q_];
        if (u + G < 4160) S5_LOADS(u + G);
#pragma unroll
        for (int mb = 0; mb < 2; ++mb) {
#pragma unroll
            for (int nb = 0; nb < 2; ++nb) {
                f32x16 are = {}, aim = {};
                are = __builtin_amdgcn_mfma_f32_32x32x16_bf16(afr[mb], bfr[nb], are, 0, 0, 0);
                aim = __builtin_amdgcn_mfma_f32_32x32x16_bf16(afr[mb], bfr[nb + 2], aim, 0, 0, 0);
#pragma unroll
                for (int r = 0; r < 16; ++r) *reinterpret_cast<unsigned*>(myl + (mb * 32 + crow(r, hi)) * S5_RS + (nb * 32 + r32) * 4) = cvtpk(are[r], aim[r]);
            }
        }
        asm volatile("s_waitcnt lgkmcnt(0)" ::: "memory");
        if (MODE == 0) { hr = 0.f; hi_ = 0.f; }
#pragma unroll 8
        for (int st = 0; st < 64; ++st) {
            const int t = dir == 0 ? st : 63 - st;
            unsigned* rowp = reinterpret_cast<unsigned*>(myl + t * S5_RS);
            const unsigned bw = rowp[lane]; const float br = bflo(bw), bi = bfhi(bw);
            const float nr = lr * hr - li * hi_ + br, ni = lr * hi_ + li * hr + bi;
            hr = nr; hi_ = ni;
            if (MODE == 1) rowp[lane] = cvtpk(hr, hi_);
        }
        if (MODE == 0) { float* E = (float*)(p->ws + WS_S5E) + ((((size_t)b * 2 + dir) * 32 + g) * NCHUNK + s5_scan_chunk(dir, tchunk)) * 128; E[lane] = hr; E[64 + lane] = hi_; }
        if (MODE == 1) {
            __syncthreads();
            if (!(l == 1 && tc4 == 0)) {
                bf16_t* YB = (bf16_t*)(p->ws + WS_YB);
#pragma unroll
                for (int mb = 0; mb < 2; ++mb) {
                    const int tl = w * 32 + mb * 16, chn = tl >> 6, tin = tl & 63;
                    f32x4 acc = {0.f, 0.f, 0.f, 0.f};
#pragma unroll
                    for (int ks = 0; ks < 8; ++ks) {
                        const int d = ks >> 2;
                        const char* src = lds + (d * 4 + chn) * (64 * S5_RS) + (tin + fr) * S5_RS + ((ks & 3) * 32 + fq * 8) * 2;
                        acc = __builtin_amdgcn_mfma_f32_16x16x32_bf16(*reinterpret_cast<const bf16x8*>(src), cfr[ks], acc, 0, 0, 0);
                    }
#pragma unroll
                    for (int j = 0; j < 4; ++j) {
                        const int row = b * NTOK + tc4 * 256 + tl + fq * 4 + j;
                        const float y = acc[j] + dpar * bf2f(uv[mb * 4 + j]);
                        const float z2 = -2.3022082f * (y + 0.044715f * y * y * y);
                        const float ge = y * __builtin_amdgcn_rcpf(1.f + __builtin_amdgcn_exp2f(z2));
                        const float go = __int_as_float(__builtin_amdgcn_mov_dpp(__float_as_int(ge), 0xB1, 0xF, 0xF, false));
                        if (!(fr & 1)) st_wt(reinterpret_cast<unsigned*>(YB + (size_t)row * 512 + g * 16 + fr), cvtpk(ge, go));
                    }
                }
            }
        }
        __syncthreads();
    }
#undef S5_LOADS
}
__device__ __forceinline__ void phase_s5a_direct(CP p, int l) {
    const int tid = otid(), w = tid >> 6, lane = tid & 63, r32 = lane & 31, hi = lane >> 5;
    const bf16_t* PL = (const bf16_t*)(p->ws + WS_PL);
    const int wg = obid() * 8 + w, nw = gridDim.x * 8;
    int cur = -1;
    bf16x8 bfr[4]; float lr[2], li[2], l4r[2], l4i[2], l5r[2], l5i[2];
    for (int wu = wg; wu < 128 * NCHUNK; wu += nw) {
        const int bdg = wu & 127, tchunk = wu >> 7, g = bdg & 31, dir = (bdg >> 5) & 1, b = bdg >> 6;
        const size_t ldg = ((size_t)l * 2 + dir) * 32 + g;
        if (bdg != cur) {
            cur = bdg;
            const bf16_t* BM = (const bf16_t*)(p->ws + WS_S5BM) + ldg * 128 * 16;
#pragma unroll
            for (int nb = 0; nb < 4; ++nb) bfr[nb] = ld16_wt(BM + (size_t)(nb * 32 + r32) * 16 + hi * 8);
#pragma unroll
            for (int st = 0; st < 2; ++st) {
                const float* LAM = (const float*)(p->ws + WS_S5LAM) + (ldg * 64 + st * 32 + r32) * 4;
                const float a = __hip_atomic_load(LAM, __ATOMIC_RELAXED, __HIP_MEMORY_SCOPE_AGENT), c = __hip_atomic_load(LAM + 1, __ATOMIC_RELAXED, __HIP_MEMORY_SCOPE_AGENT); lr[st] = a; li[st] = c;
                const float r2 = a * a - c * c, i2 = 2.f * a * c, r4 = r2 * r2 - i2 * i2, i4 = 2.f * r2 * i2;
                l4r[st] = r4; l4i[st] = i4; l5r[st] = r4 * a - i4 * c; l5i[st] = r4 * c + i4 * a;
            }
        }
        const int row0 = b * NTOK + tchunk * 64;
        float hr[2] = {0.f, 0.f}, hm[2] = {0.f, 0.f};
#pragma unroll
        for (int mb = 0; mb < 2; ++mb) {
            const int j = mb * 32 + r32, tok = dir == 0 ? j : 63 - j;
            const bf16x8 afr = *reinterpret_cast<const bf16x8*>(PL + (size_t)(row0 + tok) * INC + OFF_C + g * 16 + hi * 8);
            f32x16 acc[4];
#pragma unroll
            for (int nb = 0; nb < 4; ++nb) { f32x16 z = {}; acc[nb] = __builtin_amdgcn_mfma_f32_32x32x16_bf16(afr, bfr[nb], z, 0, 0, 0); }
#pragma unroll
            for (int r = 0; r < 16; ++r) {
                const bool big = (r & 3) == 0 && !(mb == 0 && r == 0);
#pragma unroll
                for (int st = 0; st < 2; ++st) {
                    const float ar = big ? l5r[st] : lr[st], ai = big ? l5i[st] : li[st];
                    const float nr = ar * hr[st] - ai * hm[st] + acc[st][r], ni = ar * hm[st] + ai * hr[st] + acc[2 + st][r];
                    hr[st] = nr; hm[st] = ni;
                }
            }
        }
        float er[2], ei[2];
#pragma unroll
        for (int st = 0; st < 2; ++st) {
            const float xr = hi == 0 ? l4r[st] * hr[st] - l4i[st] * hm[st] : hr[st], xi = hi == 0 ? l4r[st] * hm[st] + l4i[st] * hr[st] : hm[st];
            er[st] = half_sum(xr); ei[st] = half_sum(xi);
        }
        float* E = (float*)(p->ws + WS_S5E) + ((((size_t)b * 2 + dir) * 32 + g) * NCHUNK + s5_scan_chunk(dir, tchunk)) * 128;
        E[hi * 32 + r32] = hi == 0 ? er[0] : er[1]; E[64 + hi * 32 + r32] = hi == 0 ? ei[0] : ei[1];
    }
}
__device__ __forceinline__ void s5_carry_unit(CP p, int l, int u, char* lds) {
    const int tid = otid(), g = u & 31, dir = (u >> 5) & 1, b = u >> 6;
    const size_t sbase = (((size_t)b * 2 + dir) * 32 + g) * NCHUNK * 128;
    const float* E = (const float*)(p->ws + WS_S5E) + sbase; float* H = (float*)(p->ws + WS_S5H) + sbase;
    float* el = (float*)lds;
    for (int i = tid; i < NCHUNK * 128 / 4; i += NTHREADS) reinterpret_cast<f32x4*>(el)[i] = reinterpret_cast<const f32x4*>(E)[i];
    __syncthreads();
    if (tid < 64) {
        const float* LAM = (const float*)(p->ws + WS_S5LAM) + ((((size_t)l * 2 + dir) * 32 + g) * 64 + tid) * 4;
        const float Lr = __hip_atomic_load(LAM + 2, __ATOMIC_RELAXED, __HIP_MEMORY_SCOPE_AGENT), Li = __hip_atomic_load(LAM + 3, __ATOMIC_RELAXED, __HIP_MEMORY_SCOPE_AGENT);
        float hr = 0.f, hi_ = 0.f;
        for (int c = 0; c < NCHUNK; ++c) {
            H[c * 128 + tid] = hr; H[c * 128 + 64 + tid] = hi_;
            const float er = el[c * 128 + tid], ei = el[c * 128 + 64 + tid];
            const float nr = Lr * hr - Li * hi_ + er, ni = Lr * hi_ + Li * hr + ei;
            hr = nr; hi_ = ni;
        }
    }
    __syncthreads();
}

__device__ __forceinline__ void fft_unit(CP p, int b, int t0, int LOGN, int g, int m, char* lds) {
    const int tid = otid(), N = 1 << LOGN;
    float2* x = (float2*)lds;
    const unsigned* GT = (const unsigned*)(p->ws + WS_GT) + ((size_t)(b * 4 + g) * 64 + m) * NTOK + t0;
    for (int n = tid; n < N; n += NTHREADS) { const unsigned w = GT[n]; x[n] = make_float2(bflo(w), bfhi(w)); }
    __syncthreads();
    const float2* TW = (const float2*)(p->ws + WS_TW);
    const int tsh = 14 - LOGN;
    for (int s = 0; s < LOGN; ++s) {
        const int hb = LOGN - 1 - s, half = 1 << hb;
        float2 w = TW[((tid & (half - 1)) << s) << tsh];
        const float2 ws = TW[(((512 & (half - 1)) << s) << tsh) & 8191];
        for (int j = tid; j < N / 2; j += NTHREADS) {
            const int pos = j & (half - 1), i0 = ((j >> hb) << (hb + 1)) + pos, i1 = i0 + half;
            const float2 a = x[i0], bb = x[i1];
            const float dr = a.x - bb.x, di = a.y - bb.y;
            x[i0] = make_float2(a.x + bb.x, a.y + bb.y);
            x[i1] = make_float2(dr * w.x - di * w.y, dr * w.y + di * w.x);
            if (half > 512) { const float nx = w.x * ws.x - w.y * ws.y, ny = w.x * ws.y + w.y * ws.x; const bool wrap = ((j + NTHREADS) >> hb) != (j >> hb); w.x = wrap ? -nx : nx; w.y = wrap ? -ny : ny; }
        }
        __syncthreads();
    }
    const float scale = LOGN == 14 ? (1.f / 128.f) : (1.f / 16.f);
    bf16_t* OT = (bf16_t*)(p->ws + WS_OT) + (size_t)(b * 4 + g) * 128 * NTOK + t0;
    bf16_t* o1 = OT + (size_t)(m == 0 ? 0 : m) * NTOK; bf16_t* o2 = OT + (size_t)(m == 0 ? 64 : 128 - m) * NTOK;
    for (int k = tid * 2; k < N; k += NTHREADS * 2) {
        float va[2], vb[2];
#pragma unroll
        for (int e = 0; e < 2; ++e) {
            const int kk = k + e, kr = (int)(__brev((unsigned)kk) >> (32 - LOGN)), k2 = (N - kk) & (N - 1), k2r = (int)(__brev((unsigned)k2) >> (32 - LOGN));
            const float2 z1 = x[kr], z2 = x[k2r];
            if (m == 0) { va[e] = 0.5f * (z1.x + z2.x) * scale; vb[e] = 0.5f * (z1.y + z2.y) * scale; }
            else { va[e] = z1.x * scale; vb[e] = z2.x * scale; }
        }
        *reinterpret_cast<unsigned*>(o1 + k) = cvtpk(va[0], va[1]); *reinterpret_cast<unsigned*>(o2 + k) = cvtpk(vb[0], vb[1]);
    }
    __syncthreads();
}
__device__ __forceinline__ float2 cmulf(float2 a, float2 b) { return make_float2(a.x * b.x - a.y * b.y, a.x * b.y + a.y * b.x); }
__device__ __forceinline__ void fft16k_unit(CP p, int b, int g, int m, char* lds) {
    constexpr float CR[16] = {1.000000000e+00f, 9.807852804e-01f, 9.238795325e-01f, 8.314696123e-01f, 7.071067812e-01f, 5.555702330e-01f, 3.826834324e-01f, 1.950903220e-01f, 6.123233996e-17f, -1.950903220e-01f, -3.826834324e-01f, -5.555702330e-01f, -7.071067812e-01f, -8.314696123e-01f, -9.238795325e-01f, -9.807852804e-01f};
    constexpr float CI[16] = {-0.000000000e+00f, -1.950903220e-01f, -3.826834324e-01f, -5.555702330e-01f, -7.071067812e-01f, -8.314696123e-01f, -9.238795325e-01f, -9.807852804e-01f, -1.000000000e+00f, -9.807852804e-01f, -9.238795325e-01f, -8.314696123e-01f, -7.071067812e-01f, -5.555702330e-01f, -3.826834324e-01f, -1.950903220e-01f};
    const int tid = otid(), N = 16384, LOGN = 14, t0 = CTX;
    float2* x = (float2*)lds;
    const float2* TW = (const float2*)(p->ws + WS_TW);
    float2 v[32];
    { const unsigned* GT = (const unsigned*)(p->ws + WS_GT) + ((size_t)(b * 4 + g) * 64 + m) * NTOK + t0;
#pragma unroll
      for (int i = 0; i < 32; ++i) { const unsigned w = GT[(i << 9) | tid]; v[i] = make_float2(bflo(w), bfhi(w)); } }
#pragma unroll
    for (int s = 0; s < 5; ++s) { const int ib = 4 - s; const float2 base = TW[tid << s];
#pragma unroll
        for (int i0 = 0; i0 < 32; ++i0) if (!((i0 >> ib) & 1)) { const int i1 = i0 | (1 << ib), mm = (i0 & ((1 << ib) - 1)) << s;
            const float2 tw = cmulf(base, make_float2(CR[mm], CI[mm])), a = v[i0], bb = v[i1];
            v[i0] = make_float2(a.x + bb.x, a.y + bb.y); v[i1] = cmulf(make_float2(a.x - bb.x, a.y - bb.y), tw); } }
#pragma unroll
    for (int i = 0; i < 32; ++i) { const int n = (i << 9) | tid; x[n + (n >> 4)] = v[i]; }
    __syncthreads();
    { const int hi9 = (tid >> 4) << 9, lo = tid & 15;
#pragma unroll
      for (int i = 0; i < 32; ++i) { const int n = hi9 | (i << 4) | lo; v[i] = x[n + (n >> 4)]; }
#pragma unroll
      for (int s = 5; s < 10; ++s) { const int ib = 9 - s; const float2 base = TW[lo << s];
#pragma unroll
          for (int i0 = 0; i0 < 32; ++i0) if (!((i0 >> ib) & 1)) { const int i1 = i0 | (1 << ib), mm = (i0 & ((1 << ib) - 1)) << (s - 5);
              const float2 tw = cmulf(base, make_float2(CR[mm], CI[mm])), a = v[i0], bb = v[i1];
              v[i0] = make_float2(a.x + bb.x, a.y + bb.y); v[i1] = cmulf(make_float2(a.x - bb.x, a.y - bb.y), tw); } }
#pragma unroll
      for (int i = 0; i < 32; ++i) { const int n = hi9 | (i << 4) | lo; x[n + (n >> 4)] = v[i]; } }
    __syncthreads();
#pragma unroll
    for (int i = 0; i < 32; ++i) { const int n = ((2 * tid + (i >> 4)) << 4) | (i & 15); v[i] = x[n + (n >> 4)]; }
#pragma unroll
    for (int s = 10; s < 14; ++s) { const int ib = 13 - s;
#pragma unroll
        for (int i0 = 0; i0 < 32; ++i0) if (!((i0 >> ib) & 1)) { const int i1 = i0 | (1 << ib), mm = ((i0 & 15) & ((1 << ib) - 1)) << (s - 9);
            const float2 a = v[i0], bb = v[i1];
            v[i0] = make_float2(a.x + bb.x, a.y + bb.y); v[i1] = cmulf(make_float2(a.x - bb.x, a.y - bb.y), make_float2(CR[mm], CI[mm])); } }
#pragma unroll
    for (int i = 0; i < 32; ++i) { const int n = ((2 * tid + (i >> 4)) << 4) | (i & 15); x[n + (n >> 4)] = v[i]; }
    __syncthreads();
    const float scale = 1.f / 128.f;
    bf16_t* OT = (bf16_t*)(p->ws + WS_OT) + (size_t)(b * 4 + g) * 128 * NTOK + t0;
    bf16_t* o1 = OT + (size_t)(m == 0 ? 0 : m) * NTOK; bf16_t* o2 = OT + (size_t)(m == 0 ? 64 : 128 - m) * NTOK;
    for (int k = tid * 2; k < N; k += NTHREADS * 2) {
        float va[2], vb[2];
#pragma unroll
        for (int e = 0; e < 2; ++e) {
            const int kk = k + e, kr = (int)(__brev((unsigned)kk) >> (32 - LOGN)), k2 = (N - kk) & (N - 1), k2r = (int)(__brev((unsigned)k2) >> (32 - LOGN));
            const float2 z1 = x[kr + (kr >> 4)], z2 = x[k2r + (k2r >> 4)];
            if (m == 0) { va[e] = 0.5f * (z1.x + z2.x) * scale; vb[e] = 0.5f * (z1.y + z2.y) * scale; }
            else { va[e] = z1.x * scale; vb[e] = z2.x * scale; }
        }
        *reinterpret_cast<unsigned*>(o1 + k) = cvtpk(va[0], va[1]); *reinterpret_cast<unsigned*>(o2 + k) = cvtpk(vb[0], vb[1]);
    }
    __syncthreads();
}
__device__ __forceinline__ void fnet_transpose_unit(CP p, int b, int g, int tb, char* lds) {
    const int tid = otid();
    bf16_t* tile = (bf16_t*)lds;
    const bf16_t* OT = (const bf16_t*)(p->ws + WS_OT) + (size_t)(b * 4 + g) * 128 * NTOK + tb * 64;
    { const int c = tid >> 2, q = tid & 3;
      const u32x4 v0 = *reinterpret_cast<const u32x4*>(OT + (size_t)c * NTOK + q * 16), v1 = *reinterpret_cast<const u32x4*>(OT + (size_t)c * NTOK + q * 16 + 8);
#pragma unroll
      for (int e = 0; e < 4; ++e) { tile[(q * 16 + 2 * e) * 136 + c] = (bf16_t)(v0[e] & 0xffffu); tile[(q * 16 + 2 * e + 1) * 136 + c] = (bf16_t)(v0[e] >> 16);
                                    tile[(q * 16 + 8 + 2 * e) * 136 + c] = (bf16_t)(v1[e] & 0xffffu); tile[(q * 16 + 8 + 2 * e + 1) * 136 + c] = (bf16_t)(v1[e] >> 16); } }
    __syncthreads();
    { const int t = tid >> 3, cq = tid & 7;
      const u32x4 v0 = *reinterpret_cast<const u32x4*>(tile + t * 136 + cq * 16), v1 = *reinterpret_cast<const u32x4*>(tile + t * 136 + cq * 16 + 8);
      unsigned char* dst = (unsigned char*)(p->ws + WS_MIX) + (size_t)(b * NTOK + tb * 64 + t) * DM + 1536 + g * 128 + cq * 16;
      u32x4 w;
#pragma unroll
      for (int e = 0; e < 2; ++e) { w[e] = f2f8x4(0.25f * bflo(v0[2 * e]), 0.25f * bfhi(v0[2 * e]), 0.25f * bflo(v0[2 * e + 1]), 0.25f * bfhi(v0[2 * e + 1]));
                                    w[2 + e] = f2f8x4(0.25f * bflo(v1[2 * e]), 0.25f * bfhi(v1[2 * e]), 0.25f * bflo(v1[2 * e + 1]), 0.25f * bfhi(v1[2 * e + 1])); }
      *reinterpret_cast<u32x4*>(dst) = w; }
    __syncthreads();
}

#define EPI_LOOP for (int ai = 0; ai < 2; ++ai) for (int m = 0; m < 4; ++m) for (int bj = 0; bj < 2; ++bj) for (int n = 0; n < 2; ++n)
struct EpiBf16 {
    bf16_t* O; int ldc, brow, bcol, ncols;
    __device__ __forceinline__ void operator()(const f32x4 (&acc)[2][2][4][2], int wr, int wc, int fr, int fq) const {
#pragma unroll
        EPI_LOOP { const int row = brow + ai * 128 + wr * 64 + m * 16 + fr, col = bcol + bj * 128 + wc * 32 + n * 16 + fq * 4;
            if (col < ncols) { const f32x4 v = acc[ai][bj][m][n]; u32x2 w = {cvtpk(v[0], v[1]), cvtpk(v[2], v[3])}; *reinterpret_cast<u32x2*>(O + (size_t)row * ldc + col) = w; } }
    }
};
struct EpiIn {
    bf16_t* PL; unsigned* GT; unsigned char* VTG; int brow, bcol;
    __device__ __forceinline__ void operator()(const f32x4 (&acc)[2][2][4][2], int wr, int wc, int fr, int fq) const {
        const int b = brow / NTOK, t0 = brow - b * NTOK, r0 = wr * 64 + fr;
#pragma unroll
        for (int bj = 0; bj < 2; ++bj) {
            const int colu = __builtin_amdgcn_readfirstlane(bcol + bj * 128 + wc * 32), col = colu + fq * 4;
            if (colu < OFF_D) {
                bf16_t* base = PL + (size_t)brow * INC; const unsigned o0 = (unsigned)(r0 * INC + col);
                if (!(colu >= OFF_B + 768 && colu < OFF_C))
#pragma unroll
                for (int ai = 0; ai < 2; ++ai)
#pragma unroll
                    for (int m = 0; m < 4; ++m)
#pragma unroll
                        for (int n = 0; n < 2; ++n) { const f32x4 v = acc[ai][bj][m][n] * (1.f / 64.f); u32x2 w = {cvtpk(v[0], v[1]), cvtpk(v[2], v[3])};
                            *reinterpret_cast<u32x2*>(base + o0 + (unsigned)((ai * 128 + m * 16) * INC + n * 16)) = w; }
                if (colu >= OFF_B + 768 && colu < OFF_C) {
                    const int cv = col - (OFF_B + 768);
                    unsigned char* vb = VTG + ((size_t)(b * 2 + (cv >> 7)) * NCHUNK + (t0 >> 6) + wr) * 8192 + (cv & 127) * 64 + vt_pos(fr);
#pragma unroll
                    for (int n = 0; n < 2; ++n)
#pragma unroll
                        for (int ai = 0; ai < 2; ++ai)
#pragma unroll
                            for (int m = 0; m < 4; ++m) { const f32x4 v = acc[ai][bj][m][n] * (1.f / 64.f);
#pragma unroll
                                for (int e = 0; e < 4; ++e) vb[ai * 2 * 8192 + n * 16 * 64 + 16 * (m >> 1) + 8 * (m & 1) + e * 64] = f2f8(v[e]); }
                }
            } else if (colu < INC) {
#pragma unroll
                for (int n = 0; n < 2; ++n) {
                    const int d = col + n * 16 - OFF_D, g = d >> 7, mm = (d & 127) >> 1; unsigned* dst = GT + ((size_t)(b * 4 + g) * 64 + mm) * NTOK + t0 + r0;
#pragma unroll
                    for (int ai = 0; ai < 2; ++ai)
#pragma unroll
                        for (int m = 0; m < 4; ++m) { const f32x4 v = acc[ai][bj][m][n] * (1.f / 64.f); dst[ai * 128 + m * 16] = cvtpk(v[0], v[1]); dst[NTOK + ai * 128 + m * 16] = cvtpk(v[2], v[3]); }
                }
            }
        }
    }
};
struct EpiKV {
    unsigned char* K8M; unsigned char* VTM; int brow, head;
    __device__ __forceinline__ void operator()(const f32x4 (&acc)[2][2][4][2], int wr, int wc, int fr, int fq) const {
        const int b = brow / NTOK, t0 = brow - b * NTOK;
#pragma unroll
        EPI_LOOP { const int rl = ai * 128 + wr * 64 + m * 16 + fr, c = wc * 32 + n * 16 + fq * 4;
            const f32x4 v = acc[ai][bj][m][n];
            if (bj == 0) *reinterpret_cast<unsigned*>(K8M + (size_t)(brow + rl) * 768 + head * 192 + c) = f2f8x4(v[0], v[1], v[2], v[3]);
            else { const int t = t0 + rl; unsigned char* dst = VTM + ((size_t)(b * 4 + head) * NCHUNK + (t >> 6)) * 8192 + c * 64 + vt_pos(t & 63);
#pragma unroll
                for (int e = 0; e < 4; ++e) dst[e * 64] = f2f8(v[e]); } }
    }
};
struct EpiGlu {
    unsigned char* MIX; int brow, pn;
    __device__ __forceinline__ void operator()(const f32x4 (&acc)[2][2][4][2], int wr, int wc, int fr, int fq) const {
#pragma unroll
        for (int ai = 0; ai < 2; ++ai) for (int m = 0; m < 4; ++m) for (int n = 0; n < 2; ++n) {
            const int row = brow + ai * 128 + wr * 64 + m * 16 + fr, c = wc * 32 + n * 16 + fq * 4;
            const f32x4 a = acc[ai][0][m][n], b = acc[ai][1][m][n]; f32x4 v;
#pragma unroll
            for (int j = 0; j < 4; ++j) v[j] = a[j] * sigmoid_hw(b[j]);
            *reinterpret_cast<unsigned*>(MIX + (size_t)row * DM + 1024 + pn * 128 + c) = f2f8x4(v[0], v[1], v[2], v[3]); __builtin_amdgcn_sched_barrier(0); }
    }
};
struct EpiRes {
    CP p; int l, brow, bcol;
    __device__ __forceinline__ void operator()(const f32x4 (&acc)[2][2][4][2], int wr, int wc, int fr, int fq) const {
        int br = brow; asm volatile("" : "+s"(br));
        const float* src0 = xin_row(p, br); bf16_t* dst0 = xres_row(p, br);
        const int ldx = (br % NTOK) < CTX ? DM : 2 * DM;
        const float* g1 = mod_row(p, l, br) + 2 * 2048;
        const int r0 = wr * 64 + fr;
#pragma unroll
        for (int bj = 0; bj < 2; ++bj) {
            const int col = bcol + bj * 128 + wc * 32 + fq * 4;
            const f32x4 g0 = *reinterpret_cast<const f32x4*>(g1 + col) * (1.f / 512.f), g16 = *reinterpret_cast<const f32x4*>(g1 + col + 16) * (1.f / 512.f);
            const unsigned os = (unsigned)(r0 * DM + col), od = (unsigned)(r0 * ldx + col);
#pragma unroll
            for (int ai = 0; ai < 2; ++ai) {
                f32x4 xv[4][2];
                if (l == 0) {
#pragma unroll
                    for (int m = 0; m < 4; ++m)
#pragma unroll
                        for (int n = 0; n < 2; ++n) xv[m][n] = *reinterpret_cast<const f32x4*>(src0 + os + (unsigned)((ai * 128 + m * 16) * DM + n * 16));
                } else {
#pragma unroll
                    for (int m = 0; m < 4; ++m)
#pragma unroll
                        for (int n = 0; n < 2; ++n) { const u32x2 w = *reinterpret_cast<const u32x2*>(dst0 + od + (unsigned)((ai * 128 + m * 16) * ldx + n * 16));
                            xv[m][n] = (f32x4){bflo(w[0]), bfhi(w[0]), bflo(w[1]), bfhi(w[1])}; }
                }
#pragma unroll
                for (int m = 0; m < 4; ++m)
#pragma unroll
                    for (int n = 0; n < 2; ++n) { const f32x4 v = xv[m][n] + (n == 0 ? g0 : g16) * acc[ai][bj][m][n]; u32x2 wo = {cvtpk(v[0], v[1]), cvtpk(v[2], v[3])};
                        *reinterpret_cast<u32x2*>(dst0 + od + (unsigned)((ai * 128 + m * 16) * ldx + n * 16)) = wo; }
            }
        }
    }
};
struct EpiMoe1 {
    unsigned char* ACT; int arow0, pn;
    __device__ __forceinline__ void operator()(const f32x4 (&acc)[2][2][4][2], int wr, int wc, int fr, int fq) const {
#pragma unroll
        for (int ai = 0; ai < 2; ++ai) for (int m = 0; m < 4; ++m) for (int n = 0; n < 2; ++n) {
            const int row = arow0 + ai * 128 + wr * 64 + m * 16 + fr, c = wc * 32 + n * 16 + fq * 4;
            const f32x4 a = acc[ai][0][m][n] * (1.f / 64.f), b = acc[ai][1][m][n] * (4.f / 64.f); f32x4 v;
#pragma unroll
            for (int j = 0; j < 4; ++j) v[j] = silu_hw(a[j]) * b[j];
            *reinterpret_cast<unsigned*>(ACT + (size_t)row * 1024 + pn * 128 + c) = f2f8x4(v[0], v[1], v[2], v[3]); __builtin_amdgcn_sched_barrier(0); }
    }
};
struct EpiMoe2 {
    unsigned char* Y; const int* list; int nvalid, bcol;
    __device__ __forceinline__ void operator()(const f32x4 (&acc)[2][2][4][2], int wr, int wc, int fr, int fq) const {
#pragma unroll
        for (int ai = 0; ai < 2; ++ai) for (int m = 0; m < 4; ++m) {
            const int r = ai * 128 + wr * 64 + m * 16 + fr;
            if (r < nvalid) { const int ent = list[r]; unsigned char* dst = Y + (size_t)ent * DM + bcol;
#pragma unroll
                for (int bj = 0; bj < 2; ++bj) for (int n = 0; n < 2; ++n) {
                    const f32x4 v = acc[ai][bj][m][n] * (16.f / 128.f);
                    *reinterpret_cast<unsigned*>(dst + bj * 128 + wc * 32 + n * 16 + fq * 4) = f2f8x4(v[0], v[1], v[2], v[3]); } }
        }
    }
};

__device__ __forceinline__ void aoff_rows(int (&aoff)[2][2], int brow, int lda, int R0, int C0) {
#pragma unroll
    for (int h = 0; h < 2; ++h)
#pragma unroll
        for (int i = 0; i < 2; ++i) aoff[h][i] = (brow + h * 128 + i * 64 + R0) * lda + C0;
}

template <int WGM>
__device__ __forceinline__ bool xcd_tile(int k, int nM, int nN, int& pm, int& pn) {
    const int bid = obid(), G = gridDim.x;
    const int v = (G & 7) == 0 ? ((k << 3) + (bid & 7)) * (G >> 3) + (bid >> 3) : k * G + bid;
    if (v >= nM * nN) return false;
    const int nig = WGM * nN, gid = v / nig, fm = gid * WGM, gsz = min(nM - fm, WGM), w = v - gid * nig;
    pn = w / gsz; pm = fm + (w - pn * gsz);
    return true;
}
__device__ __forceinline__ void phase_gemm_in(CP p, int l, char* lds) {
    const bf16_t* A = (const bf16_t*)(p->ws + WS_HL); const bf16_t* Bt = (const bf16_t*)(p->ws + WS_BTIN) + (size_t)l * INCP * 1024;
    for (int k = 0;; ++k) {
        int R0, C0; stage_coords(R0, C0);
        int pm, pn; if (!xcd_tile<8>(k, 130, 11, pm, pn)) break;
        int aoff[2][2]; aoff_rows(aoff, pm * 256, 1024, R0, C0);
        EpiIn e{(bf16_t*)(p->ws + WS_PL), (unsigned*)(p->ws + WS_GT), (unsigned char*)(p->ws + WS_VTG), pm * 256, pn * 256};
        gemm_unit<false, 1024, true, 0>(A, aoff, Bt, (pn * 256 + R0) * 1024 + C0, 1024, 1024, lds, e);
    }
}
__device__ __forceinline__ void phase_gemm_qkv_up(CP p, int l, char* lds) {
    const bf16_t* A2 = (const bf16_t*)(p->ws + WS_A2);
    for (int k = 0;; ++k) {
        int R0, C0; stage_coords(R0, C0);
        int pm, pn; if (!xcd_tile<8>(k, 130, 7, pm, pn)) break;
        int aoff[2][2];
        if (pn < 3) {
            aoff_rows(aoff, pm * 256, 640, R0, C0);
            EpiBf16 e{(bf16_t*)(p->ws + WS_QM), 768, pm * 256, pn * 256, 768};
            gemm_unit<false, 640, false, 0>(A2, aoff, (const bf16_t*)(p->ws + WS_BTUQ) + (size_t)l * 768 * 384, (pn * 256 + R0) * 384 + C0, 384, 384, lds, e);
        } else {
            aoff_rows(aoff, pm * 256, 640, R0, C0 + 384);
            EpiKV e{(unsigned char*)(p->ws + WS_K8M), (unsigned char*)(p->ws + WS_VTM), pm * 256, pn - 3};
            gemm_unit<false, 640, false, 0>(A2, aoff, (const bf16_t*)(p->ws + WS_BTUKV) + (size_t)l * 1024 * 256, ((pn - 3) * 256 + R0) * 256 + C0, 256, 256, lds, e);
        }
    }
}
__device__ __forceinline__ void phase_gemm_glu(CP p, int l, char* lds) {
    const bf16_t* A = (const bf16_t*)(p->ws + WS_YB); const bf16_t* Bt = (const bf16_t*)(p->ws + WS_BTGLU) + (size_t)l * 1024 * 512;
    for (int k = 0;; ++k) {
        int R0, C0; stage_coords(R0, C0);
        int pmi, pn; if (!xcd_tile<8>(k, l == 0 ? 130 : 128, 4, pmi, pn)) break;
        const int pm = l == 0 ? pmi : pmi + 1 + (pmi >= 64);
        int aoff[2][2]; aoff_rows(aoff, pm * 256, 512, R0, C0);
        EpiGlu e{(unsigned char*)(p->ws + WS_MIX), pm * 256, pn};
        gemm_unit<false, 512, false, 0>(A, aoff, Bt, (pn * 256 + R0) * 512 + C0, 512, 512, lds, e);
    }
}
__device__ __forceinline__ void phase_gemm_out(CP p, int l, char* lds) {
    const bf16_t* A = (const bf16_t*)(p->ws + WS_MIX); const bf16_t* Bt = (const bf16_t*)(p->ws + WS_BTOUT) + (size_t)l * 2048 * 1024;
    for (int k = 0;; ++k) {
        int R0, C0; stage_coords(R0, C0);
        int pmi, pn; if (!xcd_tile<8>(k, l == 0 ? 130 : 128, 8, pmi, pn)) break;
        const int pm = l == 0 ? pmi : pmi + 1 + (pmi >= 64);
        int aoff[2][2]; aoff_rows(aoff, pm * 256, 1024, R0, C0);
        EpiRes e{p, l, pm * 256, pn * 256};
        gemm_unit<false, 1024, true, 0>(A, aoff, Bt, (pn * 256 + R0) * 1024 + C0, 1024, 1024, lds, e);
    }
}
__device__ __forceinline__ bool moe_unit(const unsigned* CNT, int u, int ntn, int& e, int& mt, int& pn, int& tbase) {
    int tb = 0;
#pragma unroll 1
    for (int x = 0; x < 16; ++x) {
        const int nt_ = ((int)CNT[x * 16] + 255) >> 8;
        if (u < (tb + nt_) * ntn) { const int v = u - tb * ntn; e = x; mt = v / ntn; pn = v % ntn; tbase = tb; return true; }
        tb += nt_;
    }
    return false;
}
__device__ __forceinline__ int moe_tiles(const unsigned* CNT) {
    int t = 0;
#pragma unroll 1
    for (int x = 0; x < 16; ++x) t += ((int)CNT[x * 16] + 255) >> 8;
    return t;
}
__device__ __forceinline__ void phase_moe1(CP p, int l, char* lds) {
    const unsigned* CNT = (const unsigned*)(p->ws + WS_CTL) + CW_CNT + l * 16 * 16;
    const int* LIST = (const int*)(p->ws + WS_LIST); const bf16_t* A = (const bf16_t*)(p->ws + WS_HL);
    const int ntiles = moe_tiles(CNT);
    for (int k = 0;; ++k) {
        int R0, C0; stage_coords(R0, C0);
        int gt, gn; if (!xcd_tile<8>(k, ntiles, 8, gt, gn)) break;
        int e, mt, pn, tb; if (!moe_unit(CNT, gt * 8 + gn, 8, e, mt, pn, tb)) break;
        const int cnt = (int)CNT[e * 16]; const int* lst = LIST + (size_t)e * MR + mt * 256;
        int aoff[2][2];
#pragma unroll
        for (int h = 0; h < 2; ++h)
#pragma unroll
            for (int i = 0; i < 2; ++i) { const int r = h * 128 + i * 64 + R0; const int ent = (mt * 256 + r < cnt) ? lst[r] : lst[0]; aoff[h][i] = (ent >> 1) * 1024 + C0; }
        EpiMoe1 ep{(unsigned char*)(p->ws + WS_ACT), (tb + mt) * 256, pn};
        gemm_unit<true, 1024, true, 0>(A, aoff, (const bf16_t*)(p->ws + WS_BTGU) + (size_t)(l * 16 + e) * 2048 * 1024, (pn * 256 + R0) * 1024 + C0, 1024, 1024, lds, ep);
    }
}
__device__ __forceinline__ void phase_moe2(CP p, int l, char* lds) {
    const unsigned* CNT = (const unsigned*)(p->ws + WS_CTL) + CW_CNT + l * 16 * 16;
    const int* LIST = (const int*)(p->ws + WS_LIST); const bf16_t* A = (const bf16_t*)(p->ws + WS_ACT);
    const int ntiles = moe_tiles(CNT);
    for (int k = 0;; ++k) {
        int R0, C0; stage_coords(R0, C0);
        int gt, gn; if (!xcd_tile<8>(k, ntiles, 8, gt, gn)) break;
        int e, mt, pn, tb; if (!moe_unit(CNT, gt * 8 + gn, 8, e, mt, pn, tb)) break;
        const int cnt = (int)CNT[e * 16];
        int aoff[2][2]; aoff_rows(aoff, (tb + mt) * 256, 512, R0, C0);
        EpiMoe2 ep{(unsigned char*)(p->ws + WS_Y), LIST + (size_t)e * MR + mt * 256, cnt - mt * 256, pn * 256};
        gemm_unit<false, 512, true, 0>(A, aoff, (const bf16_t*)(p->ws + WS_BTDN) + (size_t)(l * 16 + e) * 2048 * 512, (pn * 256 + R0) * 512 + C0, 512, 512, lds, ep);
    }
}

__device__ __forceinline__ void attn_mla(CP p, int b, int h, int qb, char* lds) {
    const bf16_t* QM = (const bf16_t*)(p->ws + WS_QM); unsigned char* MIX = (unsigned char*)(p->ws + WS_MIX);
    const size_t r0 = (size_t)b * NTOK, rq = r0 + (size_t)qb * 256;
    attn_unit_f8<192, true, 768, 768, DM>(QM + rq * 768 + h * 192, (const unsigned char*)(p->ws + WS_K8M) + r0 * 768 + h * 192,
                         (const unsigned char*)(p->ws + WS_VTM) + (size_t)(b * 4 + h) * NCHUNK * 8192, MIX + rq * DM + h * 128, qb == 0 ? CTX : NTOK, (qb - 1) * 256, qb > 0, lds);
}
__device__ __forceinline__ void attn_gqa(CP p, int b, int h, int qb, char* lds) {
    const bf16_t* PL = (const bf16_t*)(p->ws + WS_PL); unsigned char* MIX = (unsigned char*)(p->ws + WS_MIX);
    const size_t r0 = (size_t)b * NTOK, rq = r0 + (size_t)qb * 256; const int kvh = h >> 1;
    attn_unit_f8<128, false, INC, 256, DM>(PL + rq * INC + OFF_B + h * 128, (const unsigned char*)(p->ws + WS_K8G) + r0 * 256 + kvh * 128,
                          (const unsigned char*)(p->ws + WS_VTG) + (size_t)(b * 2 + kvh) * NCHUNK * 8192, MIX + rq * DM + 512 + h * 128, qb == 0 ? CTX : NTOK, 0, false, lds);
}

__device__ __forceinline__ int attn_xcd_order(int u, int G) {
    if (G != 256 || u >= 512) return u;
    const int x = u & 7, j = (u >> 3) & 31;
    return (u & 256) | ((x >> 1) << 6) | ((x & 1) << 5) | j;
}
#ifndef PH_ONLY
#define PH_ONLY -1
#endif
__device__ __forceinline__ CP kparams() { CP kp = (CP)__builtin_amdgcn_kernarg_segment_ptr(); asm volatile("" : "+s"(kp)); return kp; }
#define PHASE(k) ((PH_ONLY < 0 || PH_ONLY == ((k) == 0 ? 0 : (k) == 21 ? 21 : 1 + ((k) - 1) % 10)) && p.ph_lo <= (k) && (k) < p.ph_hi)
#define SEAM(k) do { if (p.ph_lo <= (k) && (k) + 1 < p.ph_hi) xcd_barrier(bar); } while (0)

__global__ void __launch_bounds__(NTHREADS, 2) dit_fwd(Params p) {
    extern __shared__ __attribute__((aligned(16))) char lds[];
    uint4* xbw = (uint4*)(lds + LDS_BYTES - 16);
    if (threadIdx.x == 0) *xbw = make_uint4(0u, 0u, 0u, 0u);
    __syncthreads();
    XcdBarrier bar = xcd_barrier_post((unsigned*)(p.ws + WS_CTL), (volatile LAS unsigned*)xbw);
    const int G = gridDim.x;

    if (PHASE(0)) { const CP q = kparams(); prologue(q, lds); }
    SEAM(0);
#pragma unroll 1
    for (int l = 0; l < 2; ++l) {
        const int pb = 1 + 10 * l;
        if (PHASE(pb + 0)) { const CP q = kparams(); phase_norm1(q, l); }
        SEAM(pb + 0);
        if (PHASE(pb + 1)) { const CP q = kparams(); phase_gemm_in(q, l, lds); }
        SEAM(pb + 1);
        if (PHASE(pb + 2)) {
            if (p.sub & 1) { const CP q = kparams(); phase_post(q, l); }
            const int sub_ = p.sub, bid = obid();
            const CP p = kparams();
            if (sub_ & 2)
            phase_s5a_direct(p, l);
            if (sub_ & 4)
            for (int u = bid; u < 512; u += G) { const int b = u >> 8, g = (u >> 6) & 3, m = u & 63; fft16k_unit(p, b, g, m, lds); }
            if (l == 0 && (sub_ & 4)) for (int u = bid; u < 512; u += G) { const int b = u >> 8, g = (u >> 6) & 3, m = u & 63; fft_unit(p, b, 0, 8, g, m, lds); }
        }
        SEAM(pb + 2);
        if (PHASE(pb + 3)) {
            const int sub_ = p.sub, bid = obid();
            const CP p = kparams();
            if (sub_ & 1) for (int u = bid; u < 128; u += G) s5_carry_unit(p, l, u, lds);
            if (sub_ & 2) phase_gemm_qkv_up(p, l, lds);
            if (sub_ & 4) for (int u = bid; u < 2080; u += G) { const int tb = u % 260, g = (u / 260) & 3, b = u / 1040; if (l == 1 && tb < 4) continue; fnet_transpose_unit(p, b, g, tb, lds); }
        }
        SEAM(pb + 3);
        if (PHASE(pb + 4)) {
            const int sub_ = p.sub, bid = obid();
            const CP p = kparams();
            if (sub_ & 1) for (int u0 = bid; u0 < (l == 0 ? 520 : 512); u0 += G) { const int u = attn_xcd_order(u0, G); const int b = (u >> 8) & 1, h = (u >> 6) & 3, qb = u < 512 ? 1 + (u & 63) : 0; attn_mla(p, u < 512 ? b : ((u - 512) >> 2), u < 512 ? h : (u & 3), qb, lds); }
            if (sub_ & 2) for (int u0 = bid; u0 < (l == 0 ? 520 : 512); u0 += G) { const int u = attn_xcd_order(u0, G); const int b = (u >> 8) & 1, h = (u >> 6) & 3, qb = u < 512 ? 1 + (u & 63) : 0; attn_gqa(p, u < 512 ? b : ((u - 512) >> 2), u < 512 ? h : (u & 3), qb, lds); }
            if (sub_ & 4) phase_s5<1>(p, l, lds);
        }
        SEAM(pb + 4);
        if (PHASE(pb + 5)) { const CP q = kparams(); phase_gemm_glu(q, l, lds); }
        SEAM(pb + 5);
        if (PHASE(pb + 6)) { const CP q = kparams(); phase_gemm_out(q, l, lds); }
        SEAM(pb + 6);
        if (PHASE(pb + 7)) { const CP q = kparams(); phase_norm2(q, l, lds); }
        SEAM(pb + 7);
        if (PHASE(pb + 8)) { const CP q = kparams(); phase_moe1(q, l, lds); }
        SEAM(pb + 8);
        if (PHASE(pb + 9)) { const CP q = kparams(); phase_moe2(q, l, lds); }
        SEAM(pb + 9);
    }
    if (PHASE(21)) { const CP q = kparams(); phase_final(q); }
}

extern "C" void kernel_launch(void* const* d_in, const int* in_sizes, int n_in, void* d_out, int out_size, void* d_ws, size_t ws_size, hipStream_t stream) {
    static int grid = 0;
    if (grid == 0) {
        if (n_in != 31 || in_sizes[0] != NBATCH * SEQ * DM || out_size != NBATCH * SEQ * DM || ws_size < WS_END) {
            fprintf(stderr, "kernel_launch: shape mismatch (n_in %d, in0 %d, out %d, ws %zu, need %zu)\n", n_in, n_in > 0 ? in_sizes[0] : -1, out_size, ws_size, (size_t)WS_END); grid = -1; return; }
        int dev = 0, cus = 0, per_cu = 0;
        if (hipGetDevice(&dev) != hipSuccess || hipDeviceGetAttribute(&cus, hipDeviceAttributeMultiprocessorCount, dev) != hipSuccess) { grid = -1; return; }
        if (hipFuncSetAttribute((const void*)dit_fwd, hipFuncAttributeMaxDynamicSharedMemorySize, LDS_BYTES) != hipSuccess) { fprintf(stderr, "kernel_launch: hipFuncSetAttribute failed\n"); grid = -1; return; }
        if (hipOccupancyMaxActiveBlocksPerMultiprocessor(&per_cu, (const void*)dit_fwd, NTHREADS, LDS_BYTES) != hipSuccess || per_cu < 1)
            fprintf(stderr, "kernel_launch: occupancy query reports %d workgroups per CU\n", per_cu);
        (void)hipGetLastError();
        grid = cus;
    }
    if (grid < 0) return;
    (void)hipMemsetAsync((char*)d_ws + WS_CTL, 0, CTL_BYTES, stream);
    Params p{};
    for (int i = 0; i < 31; ++i) p.in[i] = (const float*)d_in[i];
    p.out = (float*)d_out; p.ws = (unsigned char*)d_ws;
#if MK_MULTI
    p.sub = -1;
    for (int k = 0; k < 22; ++k) { if (DBG_STOP && k >= DBG_STOP && k != 21) continue; p.ph_lo = k; p.ph_hi = k + 1; hipLaunchKernelGGL(dit_fwd, dim3(grid), dim3(NTHREADS), LDS_BYTES, stream, p); }
#else
    p.sub = -1;
#if PROBE_DRY
    p.dry = 0; p.ph_lo = 0; p.ph_hi = PROBE_PHASE; hipLaunchKernelGGL(dit_fwd, dim3(grid), dim3(NTHREADS), LDS_BYTES, stream, p);
    (void)hipMemsetAsync((char*)d_ws + WS_CTL, 0, 16384, stream);
    p.dry = 1; p.ph_lo = PROBE_PHASE; p.ph_hi = PROBE_PHASE + 1; p.sub = PROBE_SUB; hipLaunchKernelGGL(dit_fwd, dim3(grid), dim3(NTHREADS), LDS_BYTES, stream, p);
    (void)hipMemsetAsync((char*)d_ws + WS_CTL, 0, 16384, stream);
    p.dry = 0; p.sub = -1; p.ph_lo = PROBE_PHASE; p.ph_hi = 22; hipLaunchKernelGGL(dit_fwd, dim3(grid), dim3(NTHREADS), LDS_BYTES, stream, p);
#elif PROBE_PHASE >= 0
    p.ph_lo = 0; p.ph_hi = PROBE_PHASE + 1; hipLaunchKernelGGL(dit_fwd, dim3(grid), dim3(NTHREADS), LDS_BYTES, stream, p);
    (void)hipMemsetAsync((char*)d_ws + WS_CTL, 0, 16384, stream);
    p.ph_lo = PROBE_PHASE; p.ph_hi = PROBE_PHASE + 1; p.sub = PROBE_SUB; hipLaunchKernelGGL(dit_fwd, dim3(grid), dim3(NTHREADS), LDS_BYTES, stream, p);
    (void)hipMemsetAsync((char*)d_ws + WS_CTL, 0, 16384, stream);
    p.sub = -1; p.ph_lo = PROBE_PHASE + 1; p.ph_hi = 22; if (PROBE_PHASE < 21) hipLaunchKernelGGL(dit_fwd, dim3(grid), dim3(NTHREADS), LDS_BYTES, stream, p);
#else
    p.ph_lo = 0; p.ph_hi = 22;
    hipLaunchKernelGGL(dit_fwd, dim3(grid), dim3(NTHREADS), LDS_BYTES, stream, p);
#endif
#endif
    const hipError_t le = hipPeekAtLastError();
    if (le != hipSuccess) fprintf(stderr, "kernel_launch: launch failed: %s\n", hipGetErrorName(le));
}
```
